# Optimizing an MI355X kernel written in HIP

```python
import math
import jax, jax.numpy as jnp
from jax import lax
import numpy as np

D_MODEL = 2048
BATCH = 4
SEQ = 2048
DEPTH = 1
DEC_BATCH = 8
DEC_SEQ = 1
PAST_LEN = 16384
PAGE_SIZE = 128

ATT_WIDTH = D_MODEL // 2
CONV_WIDTH = D_MODEL - ATT_WIDTH
HEAD_DIM = 64
QK_DIM = 2 * HEAD_DIM
V_DIM = 2 * HEAD_DIM
N_HEADS = ATT_WIDTH // V_DIM
ROT_DIM = HEAD_DIM // 4
ROPE_THETA = 500000.0
CONV_KERNEL = 31
PLE_DIM = 256
Q_BLOCK = 128
EPS = 1e-6
D_IN = 4 * ATT_WIDTH + 3 * CONV_WIDTH
IN_SPLITS = (ATT_WIDTH, 2 * ATT_WIDTH, 3 * ATT_WIDTH, 4 * ATT_WIDTH, 4 * ATT_WIDTH + 2 * CONV_WIDTH)
NEG_INF = -1e30

kernel_name = "hymba_diffattn_conformer_decode_step"


def rms_norm(x, g):
    xf = x.astype(jnp.float32)
    y = xf * lax.rsqrt(jnp.mean(xf * xf, axis=-1, keepdims=True) + EPS)
    return (y * g.astype(jnp.float32)).astype(x.dtype)


def layer_norm(x, g, b):
    xf = x.astype(jnp.float32)
    mu = jnp.mean(xf, axis=-1, keepdims=True)
    var = jnp.mean(jnp.square(xf - mu), axis=-1, keepdims=True)
    y = (xf - mu) * lax.rsqrt(var + EPS)
    return (y * g.astype(jnp.float32) + b.astype(jnp.float32)).astype(x.dtype)


def partial_rope(x, pos):
    inv = ROPE_THETA ** (-jnp.arange(0, ROT_DIM, 2, dtype=jnp.float32) / ROT_DIM)
    ang = pos.astype(jnp.float32)[:, None] * inv[None, :]
    cos = jnp.cos(ang)[None, :, None, None, :]
    sin = jnp.sin(ang)[None, :, None, None, :]
    xr = x[..., :ROT_DIM].astype(jnp.float32)
    x1, x2 = xr[..., : ROT_DIM // 2], xr[..., ROT_DIM // 2:]
    rot = jnp.concatenate([x1 * cos - x2 * sin, x2 * cos + x1 * sin], axis=-1).astype(x.dtype)
    return jnp.concatenate([rot, x[..., ROT_DIM:]], axis=-1)


def diff_attend(q, k, v, q_pos, k_pos, lam):
    s = jnp.einsum("bqhmd,bkhmd->bhmqk", q, k).astype(jnp.float32) * (HEAD_DIM ** -0.5)
    mask = k_pos[None, :] <= q_pos[:, None]
    s = jnp.where(mask, s, NEG_INF)
    p = jax.nn.softmax(s, axis=-1)
    a = p[:, :, 0] - lam * p[:, :, 1]
    return jnp.einsum("bhqk,bkhe->bqhe", a.astype(v.dtype), v)


def prompt_attention(q, k, v, pos, lam):
    b, s = q.shape[0], q.shape[1]
    nqb = s // Q_BLOCK
    qb = q.reshape(b, nqb, Q_BLOCK, N_HEADS, 2, HEAD_DIM).transpose(1, 0, 2, 3, 4, 5)
    pb = pos.reshape(nqb, Q_BLOCK)
    out = lax.map(lambda xs: diff_attend(xs[0], k, v, xs[1], pos, lam), (qb, pb))
    return out.transpose(1, 0, 2, 3, 4).reshape(b, s, N_HEADS, V_DIM)


def causal_dwconv(hist, w_dw, b_dw):
    y = lax.conv_general_dilated(hist, w_dw[:, None, :].astype(hist.dtype), window_strides=(1,),
                                 padding="VALID", dimension_numbers=("NWC", "WIO", "NWC"),
                                 feature_group_count=CONV_WIDTH)
    return y + b_dw


def mixer_layer(h, p_l, pos, conv_hist, attn_fn, layer_idx, w_in, g_norm, lam_q1, lam_k1, lam_q2, lam_k2,
                g_subln, w_dw, b_dw, g_cln, b_cln, w_pw, w_out, g_ple, w_pg, w_ple):
    b, s, _ = h.shape
    u = rms_norm(h, g_norm)
    z = u @ w_in
    q, k, v, gate_a, cu, gate_c = jnp.split(z, IN_SPLITS, axis=-1)
    q = partial_rope(q.reshape(b, s, N_HEADS, 2, HEAD_DIM), pos)
    k = partial_rope(k.reshape(b, s, N_HEADS, 2, HEAD_DIM), pos)
    v = v.reshape(b, s, N_HEADS, V_DIM)
    lam_init = 0.8 - 0.6 * math.exp(-0.3 * layer_idx)
    lam = (jnp.exp(jnp.sum(lam_q1.astype(jnp.float32) * lam_k1.astype(jnp.float32)))
           - jnp.exp(jnp.sum(lam_q2.astype(jnp.float32) * lam_k2.astype(jnp.float32))) + lam_init)
    o = attn_fn(q, k, v, lam)
    o = rms_norm(o, g_subln) * (1.0 - lam_init)
    o_att = o.reshape(b, s, ATT_WIDTH) * jax.nn.silu(gate_a)
    ca, cb = jnp.split(cu, 2, axis=-1)
    g = ca * jax.nn.sigmoid(cb)
    hist = jnp.concatenate([conv_hist.astype(g.dtype), g], axis=1)
    c = causal_dwconv(hist, w_dw, b_dw)
    c = jax.nn.silu(layer_norm(c, g_cln, b_cln)) @ w_pw
    o_conv = c * jax.nn.silu(gate_c)
    h = h + jnp.concatenate([o_att, o_conv], axis=-1) @ w_out
    gate = jax.nn.sigmoid(rms_norm(h, g_ple) @ w_pg)
    h = h + gate * (p_l @ w_ple)
    new_conv = hist[:, -(CONV_KERNEL - 1):]
    return h, k.reshape(b, s, N_HEADS, QK_DIM), v, new_conv


def setup_inputs(seed: int = 0) -> dict:
    key = jax.random.key(seed)
    ks = jax.random.split(key, 32)
    n_pages = PAST_LEN // PAGE_SIZE
    n_used = DEC_BATCH * n_pages
    n_pool = n_used + n_used // 4
    f32 = jnp.float32
    nrm = lambda k, shp, sc: jax.random.normal(k, shp, f32) * sc
    perm = jax.random.permutation(ks[0], n_pool)[:n_used]
    return {
        "x_prompt": nrm(ks[1], (BATCH, SEQ, D_MODEL), 1.0),
        "x_sample": nrm(ks[2], (DEC_BATCH, DEC_SEQ, D_MODEL), 1.0),
        "p_prompt": nrm(ks[3], (DEPTH, BATCH, SEQ, PLE_DIM), 1.0),
        "p_sample": nrm(ks[4], (DEPTH, DEC_BATCH, DEC_SEQ, PLE_DIM), 1.0),
        "cache_k": nrm(ks[5], (DEPTH, n_pool, PAGE_SIZE, N_HEADS, QK_DIM), 1.0),
        "cache_v": nrm(ks[6], (DEPTH, n_pool, PAGE_SIZE, N_HEADS, V_DIM), 1.0),
        "state_conv": nrm(ks[7], (DEPTH, DEC_BATCH, CONV_KERNEL - 1, CONV_WIDTH), 1.0),
        "page_table": perm.reshape(DEC_BATCH, n_pages).astype(jnp.int32),
        "w_in": nrm(ks[8], (DEPTH, D_MODEL, D_IN), D_MODEL ** -0.5),
        "g_norm": 1.0 + nrm(ks[9], (DEPTH, D_MODEL), 0.02),
        "lam_q1": nrm(ks[10], (DEPTH, HEAD_DIM), 0.1),
        "lam_k1": nrm(ks[11], (DEPTH, HEAD_DIM), 0.1),
        "lam_q2": nrm(ks[12], (DEPTH, HEAD_DIM), 0.1),
        "lam_k2": nrm(ks[13], (DEPTH, HEAD_DIM), 0.1),
        "g_subln": 1.0 + nrm(ks[14], (DEPTH, V_DIM), 0.02),
        "w_dw": nrm(ks[15], (DEPTH, CONV_KERNEL, CONV_WIDTH), CONV_KERNEL ** -0.5),
        "b_dw": nrm(ks[16], (DEPTH, CONV_WIDTH), 0.02),
        "g_cln": 1.0 + nrm(ks[17], (DEPTH, CONV_WIDTH), 0.02),
        "b_cln": nrm(ks[18], (DEPTH, CONV_WIDTH), 0.02),
        "w_pw": nrm(ks[19], (DEPTH, CONV_WIDTH, CONV_WIDTH), CONV_WIDTH ** -0.5),
        "w_out": nrm(ks[20], (DEPTH, ATT_WIDTH + CONV_WIDTH, D_MODEL), (ATT_WIDTH + CONV_WIDTH) ** -0.5),
        "g_ple": 1.0 + nrm(ks[21], (DEPTH, D_MODEL), 0.02),
        "w_pg": nrm(ks[22], (DEPTH, D_MODEL, D_MODEL), D_MODEL ** -0.5),
        "w_ple": nrm(ks[23], (DEPTH, PLE_DIM, D_MODEL), PLE_DIM ** -0.5),
        "g_final": 1.0 + nrm(ks[24], (D_MODEL,), 0.02),
    }


def reference(x_prompt, x_sample, p_prompt, p_sample, cache_k, cache_v, state_conv, page_table,
              w_in, g_norm, lam_q1, lam_k1, lam_q2, lam_k2, g_subln, w_dw, b_dw, g_cln, b_cln,
              w_pw, w_out, g_ple, w_pg, w_ple, g_final):
    n_pages = PAST_LEN // PAGE_SIZE
    past = n_pages * PAGE_SIZE
    pos_p = jnp.arange(SEQ, dtype=jnp.int32)
    pos_s = PAST_LEN + jnp.arange(DEC_SEQ, dtype=jnp.int32)
    k_pos_s = jnp.arange(past + DEC_SEQ, dtype=jnp.int32)
    h_p, h_s = x_prompt, x_sample
    nk_p, nv_p, nc_p, nk_s, nv_s, nc_s = [], [], [], [], [], []
    for i in range(DEPTH):
        params = (w_in[i], g_norm[i], lam_q1[i], lam_k1[i], lam_q2[i], lam_k2[i], g_subln[i],
                  w_dw[i], b_dw[i], g_cln[i], b_cln[i], w_pw[i], w_out[i], g_ple[i], w_pg[i], w_ple[i])

        def prompt_attn(q, k, v, lam):
            return prompt_attention(q, k, v, pos_p, lam)

        ck, cv = cache_k[i], cache_v[i]

        def sample_attn(q, k, v, lam, ck=ck, cv=cv):
            pk = ck[page_table].reshape(DEC_BATCH, past, N_HEADS, 2, HEAD_DIM).astype(k.dtype)
            pv = cv[page_table].reshape(DEC_BATCH, past, N_HEADS, V_DIM).astype(v.dtype)
            k_all = jnp.concatenate([pk, k], axis=1)
            v_all = jnp.concatenate([pv, v], axis=1)
            return diff_attend(q, k_all, v_all, pos_s, k_pos_s, lam)

        zero_hist = jnp.zeros((BATCH, CONV_KERNEL - 1, CONV_WIDTH), x_prompt.dtype)
        h_p, kp, vp, cp = mixer_layer(h_p, p_prompt[i], pos_p, zero_hist, prompt_attn, i, *params)
        h_s, ks_, vs_, cs_ = mixer_layer(h_s, p_sample[i], pos_s, state_conv[i], sample_attn, i, *params)
        nk_p.append(kp); nv_p.append(vp); nc_p.append(cp)
        nk_s.append(ks_); nv_s.append(vs_); nc_s.append(cs_)
    y_prompt = rms_norm(h_p, g_final)
    y_sample = rms_norm(h_s, g_final)
    new_k_prompt = jnp.stack(nk_p)
    new_v_prompt = jnp.stack(nv_p)
    new_conv_prompt = jnp.stack(nc_p)
    new_k_sample = jnp.stack(nk_s)
    new_v_sample = jnp.stack(nv_s)
    new_conv_sample = jnp.stack(nc_s)
    return (y_prompt, y_sample, new_k_prompt, new_v_prompt, new_conv_prompt, new_k_sample, new_v_sample, new_conv_sample)
```

```cpp
#include <hip/hip_runtime.h>
#include <hip/hip_bf16.h>
#include <cstdio>
#include <cstdint>
#include <cmath>
constexpr int NWAVES = 8, NTHR = NWAVES * 64;
constexpr int MPR = 8192, MV = 8200, MP = 8448;
constexpr int DMOD = 2048, DIN = 7168, AWD = 1024, PLED = 256, SEQL = 2048;
constexpr float EPSN = 1e-6f;
constexpr float C2Q = 0.125f * 1.4426950408889634f;
constexpr size_t OY = 0, OYS = 16777216, ONK = 16793600, ONV = 25182208, ONC = 33570816, ONKS = 33693696, ONVS = 33701888, ONCS = 33710080, OUT_TOTAL = 33955840;
constexpr size_t MiB = 1u << 20;
constexpr size_t WS_CTL = 0, CTL_ZERO_BYTES = 1 * MiB;
constexpr size_t WS_WIN = 2 * MiB, WS_WPW = 30 * MiB, WS_WOUT = 32 * MiB, WS_WPG = 40 * MiB, WS_WPLE = 48 * MiB;
constexpr size_t WS_RS0 = 49 * MiB, WS_SS1 = WS_RS0 + 64 * 1024, WS_SS2 = WS_SS1 + 512 * 1024, WS_ROPE = WS_SS2 + 512 * 1024, WS_ZS = WS_ROPE + 256 * 1024,
                 WS_H1S = WS_ZS + 128 * 1024, WS_SS1S = WS_H1S + 64 * 1024, WS_SS2S = WS_SS1S + 4096, WS_PART = 52 * MiB;
constexpr size_t WS_XB = 64 * MiB, WS_PB = 97 * MiB, WS_Q = 102 * MiB, WS_K = 119 * MiB, WS_V = 136 * MiB, WS_GA = 153 * MiB, WS_G = 170 * MiB, WS_GC = 187 * MiB, WS_A2 = 204 * MiB,
                 WS_OM = 221 * MiB, WS_A3 = 253 * MiB, WS_PLE = 286 * MiB, WS_H1B = 319 * MiB, WS_END = 352 * MiB;
constexpr int CW_TMO = 0, CW_BAR = 4096;
namespace pg8 {
#define PG8_LAS __attribute__((address_space(3)))
typedef unsigned short bf16_t;
typedef short bf16x8 __attribute__((ext_vector_type(8)));
typedef float f32x4 __attribute__((ext_vector_type(4)));
typedef unsigned u32x4 __attribute__((ext_vector_type(4)));
constexpr int BM = 256, BK = 64, HALF = 128, HTB = HALF * BK * 2  , STAGE_BYTES = 8 * HTB, NXCD = 8, WGM = 8;

__host__ __device__ __forceinline__ int lds_byte(int r, int c) { const int st = (r >> 4) * 2 + (c >> 5), rr = r & 15, cc = c & 31, ob = rr * 64 + cc * 2; return st * 1024 + (ob ^ (((ob >> 9) & 1) << 5)); }
__host__ __device__ __forceinline__ void stage_rc(int b, int& R, int& C) { const int st = b / 1024, sb = b % 1024, swz = sb ^ (((sb >> 9) & 1) << 5); R = (st >> 1) * 16 + swz / 64; C = (st & 1) * 32 + (swz % 64) / 2; }
__host__ __device__ __forceinline__ int perm32(int rho) { const int n = rho >> 4, i = rho & 15; return 8 * (i >> 2) + 4 * n + (i & 3); }

struct Unit { int pm, pn; };
struct Gemm { const bf16_t* A; const bf16_t* Bt; int M, N, K; };

struct StaticOrder {
    int nM, nN, nwg, G, c;
    __host__ __device__ void init(int M, int N, int G_, int c_) { nM = M / BM; nN = N / BM; nwg = nM * nN; G = G_; c = c_; }
    __host__ __device__ bool next(int i, Unit& u) const {
        const long L = (long)i * G + c; if (L >= nwg) return false;
        int wgid = (int)L; { const int q = nwg / NXCD, r = nwg % NXCD, xcd = wgid % NXCD, off = wgid / NXCD; wgid = (xcd < r ? xcd * (q + 1) : r * (q + 1) + (xcd - r) * q) + off; }
        const int nig = WGM * nN, gid = wgid / nig, fm = gid * WGM, gsz = (nM - fm) < WGM ? (nM - fm) : WGM;
        u.pm = fm + ((wgid % nig) % gsz); u.pn = (wgid % nig) / gsz; return true;
    }
    __device__ __forceinline__ void a_ready(const Unit&) const {}
    __device__ __forceinline__ void done(const Unit&) const {}
};

__device__ __forceinline__ unsigned cvt_pk_bf16(float lo, float hi) { unsigned r; asm volatile("v_cvt_pk_bf16_f32 %0, %1, %2" : "=v"(r) : "v"(lo), "v"(hi)); return r; }
typedef float f32x2 __attribute__((ext_vector_type(2)));
__device__ __forceinline__ f32x2 gelu_pk(f32x2 v) {
    const f32x2 av = __builtin_elementwise_abs(v), d = av * 0.2316418882f + 1.0f;
    f32x2 t; t.x = __builtin_amdgcn_rcpf(d.x); t.y = __builtin_amdgcn_rcpf(d.y);
    f32x2 q = t * 0.5307027145f + (-0.7265760135f); q = q * t + 0.7107068705f; q = q * t + (-0.142248368f); q = q * t + 0.127414796f; q = q * t;
    const f32x2 s = (v * v) * (-0.72134752044f);
    f32x2 e; e.x = __builtin_amdgcn_exp2f(s.x); e.y = __builtin_amdgcn_exp2f(s.y);
    const f32x2 m = v * (q * e), r = v - m;
    f32x2 o; o.x = v.x < 0.f ? m.x : r.x; o.y = v.y < 0.f ? m.y : r.y; return o;
}

template <int ACT  > struct EpiBf16 {
    static constexpr bool PERM = true, AFTER_DRAIN = false; static_assert(ACT == 0 || ACT == 1, "EpiBf16: ACT is 0 (none) or 1 (gelu_pk)");
    bf16_t* O; int ldc; const float* bias; int split_cols; size_t split_stride; float scale0;
    __device__ __forceinline__ void operator()(const f32x4 (&acc)[2][2][4][2], const Unit& u, int wr, int wc, int fr, int fq) const {
        const int row0 = u.pm * BM + wr * 64 + fr; int colt = u.pn * BM; bf16_t* base = O;
        float sc = 1.f; if (split_cols) { const int t = colt / split_cols; base += (size_t)t * split_stride; colt -= t * split_cols; if (t == 0) sc = scale0; }
        const int col0 = colt + wc * 32 + 8 * fq, bcol0 = u.pn * BM + wc * 32 + 8 * fq;
        f32x4 bv[2][2];
#pragma unroll
        for (int bj = 0; bj < 2; ++bj)
#pragma unroll
            for (int n = 0; n < 2; ++n) bv[bj][n] = bias ? *(const f32x4*)(bias + bcol0 + bj * HALF + 4 * n) : (f32x4){0.f, 0.f, 0.f, 0.f};
#pragma unroll
        for (int ai = 0; ai < 2; ++ai)
#pragma unroll
            for (int m = 0; m < 4; ++m) { bf16_t* rowp = base + (size_t)(row0 + ai * HALF + m * 16) * ldc + col0;
#pragma unroll
                for (int bj = 0; bj < 2; ++bj) { f32x4 v0 = acc[ai][bj][m][0] + bv[bj][0], v1 = acc[ai][bj][m][1] + bv[bj][1];
                    if (ACT == 1) { f32x2 a = gelu_pk((f32x2){v0[0], v0[1]}), b = gelu_pk((f32x2){v0[2], v0[3]}), c = gelu_pk((f32x2){v1[0], v1[1]}), d = gelu_pk((f32x2){v1[2], v1[3]});
                        v0 = (f32x4){a.x, a.y, b.x, b.y}; v1 = (f32x4){c.x, c.y, d.x, d.y}; }
                    v0 = v0 * sc; v1 = v1 * sc; u32x4 w; w.x = cvt_pk_bf16(v0[0], v0[1]); w.y = cvt_pk_bf16(v0[2], v0[3]); w.z = cvt_pk_bf16(v1[0], v1[1]); w.w = cvt_pk_bf16(v1[2], v1[3]);
                    *(u32x4*)(rowp + bj * HALF) = w; } }
    }
};

constexpr int E_MV = 8200;
constexpr float E_C2 = 0.125f * 1.4426950408889634f;
__device__ __forceinline__ float sigm(float x) { return __builtin_amdgcn_rcpf(1.f + __expf(-x)); }
__device__ __forceinline__ float silu(float x) { return x * sigm(x); }
__device__ __forceinline__ u32x4 pack8(const f32x4 a, const f32x4 b) { u32x4 w; w.x = cvt_pk_bf16(a[0], a[1]); w.y = cvt_pk_bf16(a[2], a[3]); w.z = cvt_pk_bf16(b[0], b[1]); w.w = cvt_pk_bf16(b[2], b[3]); return w; }
__device__ __forceinline__ void unpack8(const u32x4 w, f32x4& a, f32x4& b) {
    a[0] = __uint_as_float(w.x << 16); a[1] = __uint_as_float(w.x & 0xffff0000u); a[2] = __uint_as_float(w.y << 16); a[3] = __uint_as_float(w.y & 0xffff0000u);
    b[0] = __uint_as_float(w.z << 16); b[1] = __uint_as_float(w.z & 0xffff0000u); b[2] = __uint_as_float(w.w << 16); b[3] = __uint_as_float(w.w & 0xffff0000u); }

struct EpiIn {
    static constexpr bool PERM = true, AFTER_DRAIN = false;
    unsigned char* ws; float* out;
    __device__ __forceinline__ void operator()(const f32x4 (&acc)[2][2][4][2], const Unit& u, int wr, int wc, int fr_in, int fq_in) const {
        int fr = fr_in, fq = fq_in; asm volatile("" : "+v"(fr), "+v"(fq));
        const int pn = u.pn; const bool samp = (u.pm == 32);
        const float* rs = (const float*)(ws + WS_RS0); const float* rope = (const float*)(ws + WS_ROPE); float* zs = (float*)(ws + WS_ZS);
        bf16_t* Q = (bf16_t*)(ws + WS_Q); bf16_t* K = (bf16_t*)(ws + WS_K); bf16_t* V = (bf16_t*)(ws + WS_V); bf16_t* GA = (bf16_t*)(ws + WS_GA); bf16_t* G = (bf16_t*)(ws + WS_G); bf16_t* GC = (bf16_t*)(ws + WS_GC);
        float* nk = out + ONK; float* nv = out + ONV; float* nconv = out + ONC; float* nks = out + ONKS; float* nvs = out + ONVS;
        const int rbase = u.pm * BM + wr * 64 + fr, cl = wc * 32 + 8 * fq;
        if (pn < 8) {
            const bool isk = pn >= 4; const int colt = (pn & 3) * 256; const bool rot = (wc & 1) == 0;
#pragma unroll
            for (int ai = 0; ai < 2; ++ai)
#pragma unroll
                for (int m = 0; m < 4; ++m) {
                    const int row = rbase + ai * HALF + m * 16; const float rsv = rs[row]; const int pos = samp ? 2048 : (row & 2047);
                    f32x4 c0 = {1.f, 1.f, 1.f, 1.f}, c1 = c0, s0 = {0.f, 0.f, 0.f, 0.f}, s1 = s0;
                    if (rot) { const f32x4* rp = (const f32x4*)(rope + pos * 16); c0 = rp[0]; c1 = rp[1]; s0 = rp[2]; s1 = rp[3]; }
#pragma unroll
                    for (int bj = 0; bj < 2; ++bj) {
                        f32x4 v0 = acc[ai][bj][m][0] * rsv, v1 = acc[ai][bj][m][1] * rsv;
                        if (rot) { f32x4 p0, p1;
#pragma unroll
                            for (int e = 0; e < 4; ++e) { p0[e] = __shfl_xor(v0[e], 16); p1[e] = __shfl_xor(v1[e], 16); }
                            if (fq < 2) { const float sg = fq == 0 ? -1.f : 1.f; v0 = v0 * c0 + (p0 * s0) * sg; v1 = v1 * c1 + (p1 * s1) * sg; } }
                        const int col = colt + bj * HALF + cl;
                        if (row < E_MV) {
                            if (!isk) { *(u32x4*)(Q + (size_t)row * 1024 + col) = pack8(v0 * E_C2, v1 * E_C2);
                                if (samp) { float* z = zs + (size_t)(row - 8192) * 4096 + col; *(f32x4*)z = v0; *(f32x4*)(z + 4) = v1; } }
                            else { *(u32x4*)(K + (size_t)row * 1024 + col) = pack8(v0, v1);
                                float* o = samp ? nks + (size_t)(row - 8192) * 1024 + col : nk + (size_t)row * 1024 + col; *(f32x4*)o = v0; *(f32x4*)(o + 4) = v1;
                                if (samp) { float* z = zs + (size_t)(row - 8192) * 4096 + 1024 + col; *(f32x4*)z = v0; *(f32x4*)(z + 4) = v1; } }
                        }
                    }
                }
        } else if (pn < 12) {
            const int colt = (pn - 8) * 256;
#pragma unroll
            for (int ai = 0; ai < 2; ++ai)
#pragma unroll
                for (int m = 0; m < 4; ++m) {
                    const int row = rbase + ai * HALF + m * 16; const float rsv = rs[row];
#pragma unroll
                    for (int bj = 0; bj < 2; ++bj) {
                        const f32x4 v0 = acc[ai][bj][m][0] * rsv, v1 = acc[ai][bj][m][1] * rsv; const int col = colt + bj * HALF + cl;
                        if (row < E_MV) { *(u32x4*)(V + (size_t)row * 1024 + col) = pack8(v0, v1);
                            float* o = samp ? nvs + (size_t)(row - 8192) * 1024 + col : nv + (size_t)row * 1024 + col; *(f32x4*)o = v0; *(f32x4*)(o + 4) = v1;
                            if (samp) { float* z = zs + (size_t)(row - 8192) * 4096 + 2048 + col; *(f32x4*)z = v0; *(f32x4*)(z + 4) = v1; } }
                    }
                }
        } else if (pn < 16 || pn >= 24) {
            bf16_t* O = pn < 16 ? GA : GC; const int colt = (pn < 16 ? pn - 12 : pn - 24) * 256;
#pragma unroll
            for (int ai = 0; ai < 2; ++ai)
#pragma unroll
                for (int m = 0; m < 4; ++m) {
                    const int row = rbase + ai * HALF + m * 16; const float rsv = rs[row];
#pragma unroll
                    for (int bj = 0; bj < 2; ++bj) {
                        f32x4 v0 = acc[ai][bj][m][0] * rsv, v1 = acc[ai][bj][m][1] * rsv;
#pragma unroll
                        for (int e = 0; e < 4; ++e) { v0[e] = silu(v0[e]); v1[e] = silu(v1[e]); }
                        if (row < E_MV) *(u32x4*)(O + (size_t)row * 1024 + colt + bj * HALF + cl) = pack8(v0, v1);
                    }
                }
        } else {
            const int col = (pn - 16) * 128 + cl;
#pragma unroll
            for (int ai = 0; ai < 2; ++ai)
#pragma unroll
                for (int m = 0; m < 4; ++m) {
                    const int row = rbase + ai * HALF + m * 16; const float rsv = rs[row];
                    f32x4 g0, g1;
#pragma unroll
                    for (int e = 0; e < 4; ++e) { g0[e] = (acc[ai][0][m][0][e] * rsv) * sigm(acc[ai][1][m][0][e] * rsv); g1[e] = (acc[ai][0][m][1][e] * rsv) * sigm(acc[ai][1][m][1][e] * rsv); }
                    if (row < E_MV) { *(u32x4*)(G + (size_t)row * 1024 + col) = pack8(g0, g1);
                        if (samp) { float* z = zs + (size_t)(row - 8192) * 4096 + 3072 + col; *(f32x4*)z = g0; *(f32x4*)(z + 4) = g1; }
                        else { const int t = row & 2047; if (t >= 2018) { float* o = nconv + ((size_t)(row >> 11) * 30 + (t - 2018)) * 1024 + col; *(f32x4*)o = g0; *(f32x4*)(o + 4) = g1; } } }
                }
        }
    }
};

struct EpiPw {
    static constexpr bool PERM = true, AFTER_DRAIN = false;
    const bf16_t* GC; bf16_t* A3;
    __device__ __forceinline__ void operator()(const f32x4 (&acc)[2][2][4][2], const Unit& u, int wr, int wc, int fr, int fq) const {
        const int rbase = u.pm * BM + wr * 64 + fr, cb = u.pn * BM + wc * 32 + 8 * fq;
#pragma unroll
        for (int ai = 0; ai < 2; ++ai)
#pragma unroll
            for (int m = 0; m < 4; ++m) {
                const int row = rbase + ai * HALF + m * 16;
#pragma unroll
                for (int bj = 0; bj < 2; ++bj) { const int col = cb + bj * HALF; f32x4 g0, g1; unpack8(*(const u32x4*)(GC + (size_t)row * 1024 + col), g0, g1);
                    *(u32x4*)(A3 + (size_t)row * 2048 + 1024 + col) = pack8(acc[ai][bj][m][0] * g0, acc[ai][bj][m][1] * g1); }
            }
    }
};

struct EpiOut {
    static constexpr bool PERM = true, AFTER_DRAIN = true;
    const float* x; float* h1; bf16_t* h1b; float* ss;
    __device__ __forceinline__ void fused(f32x4 (&acc)[2][2][4][2], const Unit& u, int wr, int wc, int fr, int fq, PG8_LAS unsigned char* lds, int wid, int lane) const {
        PG8_LAS float* P = (PG8_LAS float*)lds;
        const int rbase = u.pm * BM + wr * 64 + fr, cb = u.pn * BM + wc * 32 + 8 * fq;
#pragma unroll
        for (int ai = 0; ai < 2; ++ai)
#pragma unroll
            for (int m = 0; m < 4; ++m) {
                const int row = rbase + ai * HALF + m * 16; float s = 0.f;
#pragma unroll
                for (int bj = 0; bj < 2; ++bj) { const size_t off = (size_t)row * 2048 + cb + bj * HALF;
                    const f32x4 v0 = acc[ai][bj][m][0] + *(const f32x4*)(x + off), v1 = acc[ai][bj][m][1] + *(const f32x4*)(x + off + 4);
                    s += (v0[0] * v0[0] + v0[1] * v0[1]) + (v0[2] * v0[2] + v0[3] * v0[3]) + (v1[0] * v1[0] + v1[1] * v1[1]) + (v1[2] * v1[2] + v1[3] * v1[3]);
                    *(f32x4*)(h1 + off) = v0; *(f32x4*)(h1 + off + 4) = v1; *(u32x4*)(h1b + off) = pack8(v0, v1); }
                s += __shfl_xor(s, 16); s += __shfl_xor(s, 32);
                if (fq == 0) P[(ai * HALF + wr * 64 + m * 16 + fr) * 4 + wc] = s;
            }
        asm volatile("s_waitcnt lgkmcnt(0)" ::: "memory"); __builtin_amdgcn_s_barrier(); asm volatile("" ::: "memory");
        const int t = wid * 64 + lane;
        if (t < 256) ss[(size_t)(u.pm * BM + t) * 8 + u.pn] = (P[t * 4] + P[t * 4 + 1]) + (P[t * 4 + 2] + P[t * 4 + 3]);
    }
};

struct EpiPg {
    static constexpr bool PERM = true, AFTER_DRAIN = true;
    const float* ss1; const bf16_t* ple; float* h; float* ss2;
    __device__ __forceinline__ void fused(f32x4 (&acc)[2][2][4][2], const Unit& u, int wr, int wc, int fr, int fq, PG8_LAS unsigned char* lds, int wid, int lane) const {
        PG8_LAS float* P = (PG8_LAS float*)lds; PG8_LAS float* RS = (PG8_LAS float*)(lds + 4096);
        const int t = wid * 64 + lane;
        if (t < 256) { const f32x4* sp = (const f32x4*)(ss1 + (size_t)(u.pm * BM + t) * 8); const f32x4 a = sp[0], b = sp[1];
            RS[t] = rsqrtf(((a[0] + a[1]) + (a[2] + a[3]) + (b[0] + b[1]) + (b[2] + b[3])) * (1.f / 2048.f) + 1e-6f); }
        asm volatile("s_waitcnt lgkmcnt(0)" ::: "memory"); __builtin_amdgcn_s_barrier(); asm volatile("" ::: "memory");
        const int rbase = u.pm * BM + wr * 64 + fr, cb = u.pn * BM + wc * 32 + 8 * fq;
#pragma unroll
        for (int ai = 0; ai < 2; ++ai)
#pragma unroll
            for (int m = 0; m < 4; ++m) {
                const int rl = ai * HALF + wr * 64 + m * 16 + fr, row = rbase + ai * HALF + m * 16; const float rsv = RS[rl]; float s = 0.f;
#pragma unroll
                for (int bj = 0; bj < 2; ++bj) { const size_t off = (size_t)row * 2048 + cb + bj * HALF;
                    f32x4 p0, p1; unpack8(*(const u32x4*)(ple + off), p0, p1);
                    f32x4 v0 = *(const f32x4*)(h + off), v1 = *(const f32x4*)(h + off + 4);
#pragma unroll
                    for (int e = 0; e < 4; ++e) { v0[e] += sigm(acc[ai][bj][m][0][e] * rsv) * p0[e]; v1[e] += sigm(acc[ai][bj][m][1][e] * rsv) * p1[e]; }
                    s += (v0[0] * v0[0] + v0[1] * v0[1]) + (v0[2] * v0[2] + v0[3] * v0[3]) + (v1[0] * v1[0] + v1[1] * v1[1]) + (v1[2] * v1[2] + v1[3] * v1[3]);
                    *(f32x4*)(h + off) = v0; *(f32x4*)(h + off + 4) = v1; }
                s += __shfl_xor(s, 16); s += __shfl_xor(s, 32);
                if (fq == 0) P[rl * 4 + wc] = s;
            }
        asm volatile("s_waitcnt lgkmcnt(0)" ::: "memory"); __builtin_amdgcn_s_barrier(); asm volatile("" ::: "memory");
        if (t < 256) ss2[(size_t)(u.pm * BM + t) * 8 + u.pn] = (P[t * 4] + P[t * 4 + 1]) + (P[t * 4 + 2] + P[t * 4 + 3]);
    }
};
struct TailOrder {
    int nM, nN, G, c, c0;
    __device__ __forceinline__ bool next(int i, Unit& u) const { if (c < c0) return false; const int L = i * (G - c0) + (c - c0); if (L >= nM * nN) return false; u.pm = L % nM; u.pn = L / nM; return true; }
    __device__ __forceinline__ void a_ready(const Unit&) const {}
    __device__ __forceinline__ void done(const Unit&) const {}
};
template <class Epi, class Sched, bool ALIGN_EPI = false, bool SP2 = false>
__device__ __forceinline__ void gemm_phase(PG8_LAS unsigned char* lds, const Gemm g, const Sched& S, const Epi& E) {
    int tid_l = threadIdx.x; asm volatile("" : "+v"(tid_l));
    const int tid = tid_l, wid = __builtin_amdgcn_readfirstlane(tid >> 6), lane = tid & 63, wr = wid >> 2, wc = wid & 3, fr = lane & 15, fq = lane >> 4;
    const int K = g.K, nt = K / BK;
    unsigned voffA[2], voffB[2];
#pragma unroll
    for (int i = 0; i < 2; ++i) { int R, C; stage_rc(tid * 16 + i * 8192, R, C); const int Rb = Epi::PERM ? ((R & ~31) + perm32(R & 31)) : R;
        voffA[i] = (unsigned)(R * K + C) * 2u; voffB[i] = (unsigned)(Rb * K + C) * 2u; }
    const size_t kstep = (size_t)(BK * 2);
    const size_t hstep = (size_t)HALF * K * 2;
    const size_t tstep = 2 * hstep;
    const unsigned ldsw = (unsigned)wid * 1024u;
    const int aoff = lds_byte(wr * 64 + fr, fq * 8), boff = lds_byte(wc * 32 + fr, fq * 8);
#define PG8_SA(b, h) (((b) * 2 + (h)) * HTB)
#define PG8_SB(b, h) ((4 + (b) * 2 + (h)) * HTB)
#define PG8_STAGE(bufoff, gbase, voff) do { _Pragma("unroll") for (int _i = 0; _i < 2; ++_i) \
        __builtin_amdgcn_global_load_lds((const unsigned*)((const char*)(gbase) + (voff)[_i]), (PG8_LAS unsigned*)(lds + (bufoff) + ldsw + _i * 8192), 16, 0, 0); } while (0)
#define PG8_LDA(dst, b, h) do { _Pragma("unroll") for (int m = 0; m < 4; ++m) _Pragma("unroll") for (int k = 0; k < 2; ++k) dst[m][k] = *(const PG8_LAS bf16x8*)(lds + PG8_SA(b, h) + aoff + m * 2048 + k * 1024); } while (0)
#define PG8_LDB(dst, b, h) do { _Pragma("unroll") for (int n = 0; n < 2; ++n) _Pragma("unroll") for (int k = 0; k < 2; ++k) dst[n][k] = *(const PG8_LAS bf16x8*)(lds + PG8_SB(b, h) + boff + n * 2048 + k * 1024); } while (0)
#define PG8_MMA(ai, bj, At, Bt) do { __builtin_amdgcn_s_setprio(1); _Pragma("unroll") for (int m = 0; m < 4; ++m) _Pragma("unroll") for (int n = 0; n < 2; ++n) _Pragma("unroll") for (int k = 0; k < 2; ++k) \
        acc[ai][bj][m][n] = __builtin_amdgcn_mfma_f32_16x16x32_bf16(Bt[n][k], At[m][k], acc[ai][bj][m][n], 0, 0, 0); __builtin_amdgcn_s_setprio(0); } while (0)
#define PG8_WAIT_V(n) asm volatile("s_waitcnt vmcnt(" #n ")" ::: "memory")
#define PG8_WAIT_L(n) asm volatile("s_waitcnt lgkmcnt(" #n ")" ::: "memory")
#define PG8_BAR __builtin_amdgcn_s_barrier()
#define PG8_SCHED __builtin_amdgcn_sched_barrier(0)
    Unit cur, nxt; int ui = 0;
    if (!S.next(0, cur)) return;
    f32x4 acc[2][2][4][2];
#pragma unroll
    for (int a = 0; a < 2; ++a)
#pragma unroll
        for (int b = 0; b < 2; ++b)
#pragma unroll
            for (int m = 0; m < 4; ++m)
#pragma unroll
                for (int n = 0; n < 2; ++n) acc[a][b][m][n] = (f32x4){0.f, 0.f, 0.f, 0.f};
    bf16x8 At[4][2], B0[2][2], B1[2][2];
    const char* cA = (const char*)g.A + (size_t)cur.pm * tstep; const char* cB = (const char*)g.Bt + (size_t)cur.pn * tstep;
    S.a_ready(cur);
    if constexpr (SP2) {
        PG8_STAGE(PG8_SB(0, 0), cB, voffB); PG8_STAGE(PG8_SB(0, 1), cB + hstep, voffB); PG8_STAGE(PG8_SA(0, 0), cA, voffA); PG8_STAGE(PG8_SA(0, 1), cA + hstep, voffA);
        if (wr == 1) PG8_BAR;
        PG8_WAIT_V(2); PG8_BAR;
        PG8_STAGE(PG8_SB(1, 0), cB + kstep, voffB); PG8_STAGE(PG8_SA(1, 0), cA + kstep, voffA); PG8_STAGE(PG8_SB(1, 1), cB + hstep + kstep, voffB);
        PG8_WAIT_V(6); PG8_BAR;
    } else {
        PG8_STAGE(PG8_SB(0, 0), cB, voffB); PG8_STAGE(PG8_SA(0, 0), cA, voffA); PG8_STAGE(PG8_SB(0, 1), cB + hstep, voffB); PG8_STAGE(PG8_SA(0, 1), cA + hstep, voffA);
        if (wr == 1) PG8_BAR;
        PG8_WAIT_V(4); PG8_BAR;
        PG8_STAGE(PG8_SB(1, 0), cB + kstep, voffB); PG8_STAGE(PG8_SA(1, 0), cA + kstep, voffA); PG8_STAGE(PG8_SB(1, 1), cB + hstep + kstep, voffB);
        PG8_WAIT_V(6); PG8_BAR;
    }
    for (;;) {
        const bool has_next = S.next(ui + 1, nxt);
        const char* nA = has_next ? (const char*)g.A + (size_t)nxt.pm * tstep : cA; const char* nB = has_next ? (const char*)g.Bt + (size_t)nxt.pn * tstep : cB;
        for (int t = 0; t < nt; t += 2) {
            const bool last = (t == nt - 2);
            const char* a1 = cA + (size_t)(t + 1) * kstep;
            const char* a2 = last ? nA : cA + (size_t)(t + 2) * kstep; const char* b2 = last ? nB : cB + (size_t)(t + 2) * kstep;
            const char* a3 = a2 + kstep; const char* b3 = b2 + kstep;
            if (last && has_next) S.a_ready(nxt);
            if constexpr (SP2) {
            PG8_LDB(B0, 0, 0); PG8_LDB(B1, 0, 1); PG8_SCHED; PG8_LDA(At, 0, 0); PG8_STAGE(PG8_SA(1, 1), a1 + hstep, voffA);
            PG8_WAIT_V(8); PG8_WAIT_L(0); PG8_BAR; PG8_MMA(0, 0, At, B0); PG8_MMA(0, 1, At, B1); PG8_BAR; PG8_SCHED;
            PG8_LDA(At, 0, 1); PG8_STAGE(PG8_SB(0, 0), b2, voffB); PG8_STAGE(PG8_SB(0, 1), b2 + hstep, voffB); PG8_STAGE(PG8_SA(0, 0), a2, voffA);
            PG8_WAIT_V(8); PG8_WAIT_L(0); PG8_BAR; PG8_MMA(1, 0, At, B0); PG8_MMA(1, 1, At, B1); PG8_BAR; PG8_SCHED;
            PG8_LDB(B0, 1, 0); PG8_LDB(B1, 1, 1); PG8_SCHED; PG8_LDA(At, 1, 0); PG8_STAGE(PG8_SA(0, 1), a2 + hstep, voffA);
            PG8_WAIT_V(8); PG8_WAIT_L(0); PG8_BAR; PG8_MMA(0, 0, At, B0); PG8_MMA(0, 1, At, B1); PG8_BAR; PG8_SCHED;
            PG8_LDA(At, 1, 1); PG8_STAGE(PG8_SB(1, 0), b3, voffB); PG8_STAGE(PG8_SB(1, 1), b3 + hstep, voffB); PG8_STAGE(PG8_SA(1, 0), a3, voffA);
            PG8_WAIT_V(8); PG8_WAIT_L(0); PG8_BAR; PG8_MMA(1, 0, At, B0); PG8_MMA(1, 1, At, B1); PG8_BAR; PG8_SCHED;
            } else {
            PG8_LDB(B0, 0, 0); PG8_SCHED; PG8_LDA(At, 0, 0); PG8_STAGE(PG8_SA(1, 1), a1 + hstep, voffA);
            PG8_WAIT_L(8); PG8_BAR; PG8_WAIT_L(0); PG8_MMA(0, 0, At, B0); PG8_BAR; PG8_SCHED;
            PG8_LDB(B1, 0, 1); PG8_STAGE(PG8_SB(0, 0), b2, voffB);
            PG8_BAR; PG8_WAIT_L(0); PG8_MMA(0, 1, At, B1); PG8_BAR;
            PG8_LDA(At, 0, 1); PG8_STAGE(PG8_SA(0, 0), a2, voffA);
            PG8_BAR; PG8_WAIT_L(0); PG8_MMA(1, 0, At, B0); PG8_BAR; PG8_SCHED;
            PG8_STAGE(PG8_SB(0, 1), b2 + hstep, voffB);
            PG8_WAIT_V(6); PG8_BAR; PG8_MMA(1, 1, At, B1); PG8_BAR;
            PG8_LDB(B0, 1, 0); PG8_SCHED; PG8_LDA(At, 1, 0); PG8_STAGE(PG8_SA(0, 1), a2 + hstep, voffA);
            PG8_WAIT_L(8); PG8_BAR; PG8_WAIT_L(0); PG8_MMA(0, 0, At, B0); PG8_BAR; PG8_SCHED;
            PG8_LDB(B1, 1, 1); PG8_STAGE(PG8_SB(1, 0), b3, voffB);
            PG8_BAR; PG8_WAIT_L(0); PG8_MMA(0, 1, At, B1); PG8_BAR;
            PG8_LDA(At, 1, 1); PG8_STAGE(PG8_SA(1, 0), a3, voffA);
            PG8_BAR; PG8_WAIT_L(0); PG8_MMA(1, 0, At, B0); PG8_BAR; PG8_SCHED;
            PG8_STAGE(PG8_SB(1, 1), b3 + hstep, voffB);
            PG8_WAIT_V(6); PG8_BAR; PG8_MMA(1, 1, At, B1); PG8_BAR;
            }
        }
        if constexpr (ALIGN_EPI) { if (wr == 0) PG8_BAR; }
        if constexpr (!Epi::AFTER_DRAIN) { int fr_l = fr, fq_l = fq; asm volatile("" : "+v"(fr_l), "+v"(fq_l)); E(acc, cur, wr, wc, fr_l, fq_l); S.done(cur); }
        if (!has_next) break;
#pragma unroll
        for (int a = 0; a < 2; ++a)
#pragma unroll
            for (int b = 0; b < 2; ++b)
#pragma unroll
                for (int m = 0; m < 4; ++m)
#pragma unroll
                    for (int n = 0; n < 2; ++n) acc[a][b][m][n] = (f32x4){0.f, 0.f, 0.f, 0.f};
        cur = nxt; cA = nA; cB = nB; ++ui;
        if constexpr (ALIGN_EPI) { if (wr == 1) PG8_BAR; }
    }
    PG8_WAIT_V(0);
    if constexpr (!ALIGN_EPI) { if (wr == 0) PG8_BAR; }
    PG8_BAR;
    if constexpr (Epi::AFTER_DRAIN) { E.fused(acc, cur, wr, wc, fr, fq, lds, wid, lane); S.done(cur); }
#undef PG8_SA
#undef PG8_SB
#undef PG8_STAGE
#undef PG8_LDA
#undef PG8_LDB
#undef PG8_MMA
#undef PG8_WAIT_V
#undef PG8_WAIT_L
#undef PG8_BAR
#undef PG8_SCHED
}
}

#ifndef PG8_SP2
#define PG8_SP2 true
#endif
#ifndef PG8_ALIGN
#define PG8_ALIGN true
#endif
#include <hip/hip_bf16.h>
#include <cmath>
namespace attn_body {
using bf16=__hip_bfloat16;
using bf16x8=__attribute__((ext_vector_type(8)))short;
using s16x4=__attribute__((ext_vector_type(4)))short;
using f32x16=__attribute__((ext_vector_type(16)))float;
using u32x4=__attribute__((ext_vector_type(4)))unsigned;
constexpr int SEQ=2048,D=64,DM=1024,ODM=2048;
constexpr int NW=8,QBLK=32,QB=QBLK*NW,KVBLK=64,NQB=SEQ/QB;
constexpr int ATTN_PITCH=DM, ATTN_UNIT_ROWS=QB;
__device__ __forceinline__ int crow(int r,int hi){return (r&3)+8*(r>>2)+4*hi;}
#define SBAR() __builtin_amdgcn_sched_barrier(0)
__device__ __forceinline__ void cmask(f32x16&p0,f32x16&p1,int jb,int qrel,int hi){
  const float NEG=-INFINITY; int kb=64*jb+4*hi;
  #pragma unroll
  for(int r=0;r<16;++r){int kv=kb+(r&3)+8*(r>>2); if(kv>qrel)p0[r]=NEG; if(kv+32>qrel)p1[r]=NEG;}
}

constexpr int NSLOT=3, SLOTB=8192;
constexpr int LDS_K=0, LDS_V=NSLOT*SLOTB, LDS_WS=2*NSLOT*SLOTB, LDS_OST=LDS_WS+NW*64*4, LDS_BYTES=LDS_OST+NW*4096;
constexpr float C2=0.125f*1.4426950408889634f;
__device__ __forceinline__ void glds16(const void*gsrc,unsigned lds_dst){unsigned keep;
  asm volatile("s_mov_b32 %0, m0\n\ts_mov_b32 m0, %2\n\ts_nop 0\n\tglobal_load_lds_dwordx4 %1, off\n\ts_mov_b32 m0, %0":"=&s"(keep):"v"(gsrc),"s"(lds_dst):"memory");}
__device__ __forceinline__ float max3f(float a,float b,float c){float r;asm("v_max3_f32 %0, %1, %2, %3":"=v"(r):"v"(a),"v"(b),"v"(c));return r;}
__device__ __forceinline__ float max2f(float a,float b){float r;asm("v_max_f32_e32 %0, %1, %2":"=v"(r):"v"(a),"v"(b));return r;}
__device__ __forceinline__ float fadd_s(float a,float b){float r;asm("v_add_f32_e32 %0, %1, %2":"=v"(r):"v"(a),"v"(b));return r;}
__device__ __forceinline__ float fsub_s(float a,float b){float r;asm("v_sub_f32_e32 %0, %1, %2":"=v"(r):"v"(a),"v"(b));return r;}
typedef float f32x2_t __attribute__((ext_vector_type(2))); typedef __bf16 bf16x2_t __attribute__((ext_vector_type(2)));
__device__ __forceinline__ unsigned cvtpk_s(float lo,float hi){f32x2_t v={lo,hi};bf16x2_t b=__builtin_convertvector(v,bf16x2_t);return __builtin_bit_cast(unsigned,b);}
#define WAIT_BAR(N) asm volatile("s_waitcnt vmcnt(" #N ") lgkmcnt(0)\n\ts_barrier":::"memory")

__device__ __forceinline__ void qkt(f32x16&p0,f32x16&p1,const char*Kslot,const bf16x8*qr,const f32x16&negm,int r32,int hi){
  const char*kb=Kslot+hi*1024+r32*16;
  #pragma unroll
  for(int d0=0;d0<4;++d0){
    const bf16x8 b0=*reinterpret_cast<const bf16x8*>(kb+d0*2048);
    const bf16x8 b1=*reinterpret_cast<const bf16x8*>(kb+d0*2048+512);
    if(d0==0){p0=__builtin_amdgcn_mfma_f32_32x32x16_bf16(b0,qr[0],negm,0,0,0);p1=__builtin_amdgcn_mfma_f32_32x32x16_bf16(b1,qr[0],negm,0,0,0);}
    else{p0=__builtin_amdgcn_mfma_f32_32x32x16_bf16(b0,qr[d0],p0,0,0,0);p1=__builtin_amdgcn_mfma_f32_32x32x16_bf16(b1,qr[d0],p1,0,0,0);}}
}
typedef __attribute__((address_space(3))) const char* lds_cptr;
typedef short v4i16_t __attribute__((ext_vector_type(4)));
__device__ __forceinline__ void kload8(bf16x8*kf,lds_cptr kp){
  kf[0]=*(const __attribute__((address_space(3))) bf16x8*)(kp);      kf[1]=*(const __attribute__((address_space(3))) bf16x8*)(kp+512);
  kf[2]=*(const __attribute__((address_space(3))) bf16x8*)(kp+2048); kf[3]=*(const __attribute__((address_space(3))) bf16x8*)(kp+2560);
  kf[4]=*(const __attribute__((address_space(3))) bf16x8*)(kp+4096); kf[5]=*(const __attribute__((address_space(3))) bf16x8*)(kp+4608);
  kf[6]=*(const __attribute__((address_space(3))) bf16x8*)(kp+6144); kf[7]=*(const __attribute__((address_space(3))) bf16x8*)(kp+6656);
}
__device__ __forceinline__ void kload2(bf16x8*kf,lds_cptr kp,int j){ kf[2*j]=*(const __attribute__((address_space(3))) bf16x8*)(kp+j*2048); kf[2*j+1]=*(const __attribute__((address_space(3))) bf16x8*)(kp+j*2048+512); }
__device__ __forceinline__ s16x4 vtr(lds_cptr p){ return __builtin_bit_cast(s16x4,__builtin_amdgcn_ds_read_tr16_b64_v4i16((__attribute__((address_space(3))) v4i16_t*)p)); }
__device__ __forceinline__ float rowmax(const f32x16&p0,const f32x16&p1){
  float a=max3f(p0[0],p0[1],p1[0]),b=max3f(p0[2],p0[3],p1[1]);a=max3f(a,p1[2],p1[3]);
  #pragma unroll
  for(int r=4;r<16;r+=4){a=max3f(a,p0[r],p0[r+1]);b=max3f(b,p0[r+2],p0[r+3]);a=max3f(a,p1[r],p1[r+1]);b=max3f(b,p1[r+2],p1[r+3]);}
  const float m=max2f(a,b);
  auto rr=__builtin_amdgcn_permlane32_swap(__float_as_uint(m),__float_as_uint(m),false,false);
  return max2f(__uint_as_float(rr[0]),__uint_as_float(rr[1]));
}
__device__ __forceinline__ void pv(f32x16*o,int vb,bf16x8 pa0,bf16x8 pa1,bf16x8 pa2,bf16x8 pa3){
  #pragma unroll
  for(int d0=0;d0<2;++d0){s16x4 lo[4],hi[4];
    #pragma unroll
    for(int ks=0;ks<4;++ks){
      asm volatile("ds_read_b64_tr_b16 %0,%1 offset:%c2":"=&v"(lo[ks]):"v"(vb),"i"(d0*4096+ks*1024):"memory");
      asm volatile("ds_read_b64_tr_b16 %0,%1 offset:%c2":"=&v"(hi[ks]):"v"(vb),"i"(d0*4096+ks*1024+512):"memory");}
    asm volatile("s_waitcnt lgkmcnt(0)":::"memory");SBAR();
    #define PK(k) (bf16x8){lo[k][0],lo[k][1],lo[k][2],lo[k][3],hi[k][0],hi[k][1],hi[k][2],hi[k][3]}
    o[d0]=__builtin_amdgcn_mfma_f32_32x32x16_bf16(pa0,PK(0),o[d0],0,0,0);
    o[d0]=__builtin_amdgcn_mfma_f32_32x32x16_bf16(pa1,PK(1),o[d0],0,0,0);
    o[d0]=__builtin_amdgcn_mfma_f32_32x32x16_bf16(pa2,PK(2),o[d0],0,0,0);
    o[d0]=__builtin_amdgcn_mfma_f32_32x32x16_bf16(pa3,PK(3),o[d0],0,0,0);
    #undef PK
  }
}

#ifndef ATTN_STORE16
#define ATTN_STORE16(p,v) (*(u32x4*)(p)=(v))
#endif
template<int THRL> __device__ __forceinline__ void attn_unit(int b,int qc,int kc,int vc,int oc,int qb,const bf16*Q,const bf16*__restrict__ K,const bf16*__restrict__ V,bf16*O,char*shm){
  int tid_l=threadIdx.x; asm volatile("":"+v"(tid_l)); const int tid=tid_l,lane=tid&63,r32=lane&31,hi=lane>>5; const int wid=__builtin_amdgcn_readfirstlane(tid>>6);
  const long rowbase=(long)b*SEQ; const int q0=qb*QB;
  const bf16*Qw=Q+(rowbase+q0+wid*QBLK)*DM+qc;
  const bf16*Kh=K+rowbase*DM+kc,*Vh=V+rowbase*DM+vc;
  const unsigned lds0=(unsigned)(uintptr_t)shm;
  float*wsf=(float*)(shm+LDS_WS)+wid*64;
  const bf16*ksrc=Kh+(long)lane*DM+wid*8;
  const bf16*vsrc=Vh+(long)(16*(wid&3)+(lane>>2))*DM+(wid>>2)*32+(lane&3)*8;
  const unsigned kdst=lds0+LDS_K+wid*1024, vdst=lds0+LDS_V+wid*1024;
  #define DMA_K(t,slot) glds16(ksrc+(long)(t)*KVBLK*DM,(unsigned)__builtin_amdgcn_readfirstlane(kdst+(slot)))
  #define DMA_V(t,slot) glds16(vsrc+(long)(t)*KVBLK*DM,(unsigned)__builtin_amdgcn_readfirstlane(vdst+(slot)))
  const int vb0=(int)(lds0+LDS_V)+((lane>>4)&1)*32+(lane&3)*8+(4*hi+((lane&15)>>2))*64;
  const char*Kbase=shm+LDS_K; bf16x8 kf[8];
  const lds_cptr shm3=(lds_cptr)shm; const lds_cptr kp0=shm3+LDS_K+hi*1024+r32*16; const lds_cptr vp0=shm3+LDS_V+((lane>>4)&1)*32+(lane&3)*8+(4*hi+((lane&15)>>2))*64;
  const int NT=(q0+QB)/KVBLK;
  DMA_K(0,0);DMA_V(0,0);DMA_K(1,SLOTB);
  bf16x8 qr[4];
  #pragma unroll
  for(int d0=0;d0<4;++d0)qr[d0]=*reinterpret_cast<const bf16x8*>(&Qw[(long)r32*DM+d0*16+hi*8]);
  float mhat=0.f,l_reg=0.f;f32x16 o[2];float zf_=0.f;asm volatile("":"+v"(zf_));f32x16 zv_;
  #pragma unroll
  for(int r=0;r<16;++r)zv_[r]=zf_;
  o[0]=zv_;o[1]=zv_;f32x16 negm=zv_;asm volatile("":"+v"(negm));
  const int qrel=wid*QBLK+r32;
  #define CMASK(P0,P1,t) do{int jb_=(t)-(NT-4); if(jb_>=0)cmask(P0,P1,jb_,qrel,hi);}while(0)
  bool resc=false;
  #define START(P0,P1) do{ const float rm=rowmax(P0,P1); resc=false; \
    { const float dl=rm; mhat=fadd_s(mhat,dl); \
      _Pragma("unroll") for(int r=0;r<16;++r){P0[r]=fsub_s(P0[r],dl);P1[r]=fsub_s(P1[r],dl);} \
      _Pragma("unroll") for(int r=0;r<16;++r)negm[r]=-mhat; asm volatile("":"+v"(negm)); } \
    _Pragma("unroll") for(int r=0;r<16;++r)P0[r]=__builtin_amdgcn_exp2f(P0[r]); }while(0)
  #define RESC() do{ if(resc){ asm volatile("s_waitcnt lgkmcnt(0)":::"memory"); \
      _Pragma("unroll") for(int d_=0;d_<2;++d_) _Pragma("unroll") for(int r=0;r<16;++r)o[d_][r]*=wsf[crow(r,hi)]; } }while(0)
  f32x16 pA0,pA1,pB0,pB1;
  int sl_prev=0,sl_cur=0,sl_next=SLOTB;
  #define ROT() do{sl_prev=sl_cur;sl_cur=sl_next;sl_next=(sl_next==(NSLOT-1)*SLOTB)?0:sl_next+SLOTB;}while(0)
  DMA_K(2,2*SLOTB);
  WAIT_BAR(3);
  qkt(pA0,pA1,Kbase,qr,negm,r32,hi);asm volatile("s_nop 15\n\ts_nop 7":"+v"(pA0),"+v"(pA1));CMASK(pA0,pA1,0);
  START(pA0,pA1);
  _Pragma("unroll") for(int r=0;r<16;++r)pA1[r]=__builtin_amdgcn_exp2f(pA1[r]);
  WAIT_BAR(0);
  DMA_K(3,0);DMA_V(1,SLOTB);
  ROT();
  kload8(kf,kp0+sl_cur);
  WAIT_BAR(2);
  s16x4 vlo[8],vhi[8]; u32x4 pw0,pw1,pw2,pw3;
  #define PKW(P,B) cvtpk_s(P[B],P[B+1])
  #define PAF(k) __builtin_bit_cast(bf16x8,pw##k)
  #define VFR(i) (bf16x8){vlo[i][0],vlo[i][1],vlo[i][2],vlo[i][3],vhi[i][0],vhi[i][1],vhi[i][2],vhi[i][3]}
  #define PIN(x) asm volatile("":"+v"(x))
  #define MX3(a,b,c) __builtin_fmaxf(__builtin_fmaxf((a),(b)),(c))
  #define GAPA(MF,A0,A1,A2,A3,W0,W1,PW) do{ MF; sacc+=A0; sacc+=A1; sacc+=A2; sacc+=A3; PIN(sacc); W0; W1; PIN(PW); SBAR(); }while(0)
  #define EX(v) __builtin_amdgcn_exp2f(v)
  #define GAPB(MF,X,B) do{ MF; X[B]=EX(X[B]); X[B+1]=EX(X[B+1]); X[B+2]=EX(X[B+2]); X[B+3]=EX(X[B+3]); PIN(X); SBAR(); }while(0)
  #define VRD(i) do{ vlo[i]=vtr(vp_+(((i)>>2)*4096+((i)&3)*1024)); vhi[i]=vtr(vp_+(((i)>>2)*4096+((i)&3)*1024+512)); }while(0)
  #define KRD(G,j) do{ if(G){ kload2(kf,kp0+sl_next,j); SBAR(); } }while(0)
  #define STEP(C0,C1,P0,P1,t,GK,GV,GL) do{ SBAR(); \
    const lds_cptr vp_=vp0+sl_prev; \
    VRD(0); SBAR(); float sacc=(P0[0]+P0[1]); \
    GAPA(C0=__builtin_amdgcn_mfma_f32_32x32x16_bf16(kf[0],qr[0],negm,0,0,0), P0[2],P0[3],P0[4],P0[5],     pw0[0]=PKW(P0,0), pw0[1]=PKW(P0,2), pw0); \
    VRD(4); SBAR(); GAPA(C1=__builtin_amdgcn_mfma_f32_32x32x16_bf16(kf[1],qr[0],negm,0,0,0), P0[6],P0[7],P0[8],P0[9],     pw0[2]=PKW(P0,4), pw0[3]=PKW(P0,6), pw0); \
    VRD(1); SBAR(); GAPA(C0=__builtin_amdgcn_mfma_f32_32x32x16_bf16(kf[2],qr[1],C0,0,0,0),   P0[10],P0[11],P0[12],P0[13], pw1[0]=PKW(P0,8), pw1[1]=PKW(P0,10), pw1); \
    VRD(5); SBAR(); GAPA(C1=__builtin_amdgcn_mfma_f32_32x32x16_bf16(kf[3],qr[1],C1,0,0,0),   P0[14],P0[15],P1[0],P1[1],   pw1[2]=PKW(P0,12),pw1[3]=PKW(P0,14), pw1); \
    VRD(2); SBAR(); GAPA(C0=__builtin_amdgcn_mfma_f32_32x32x16_bf16(kf[4],qr[2],C0,0,0,0),   P1[2],P1[3],P1[4],P1[5],     pw2[0]=PKW(P1,0), pw2[1]=PKW(P1,2), pw2); \
    VRD(6); SBAR(); GAPA(C1=__builtin_amdgcn_mfma_f32_32x32x16_bf16(kf[5],qr[2],C1,0,0,0),   P1[6],P1[7],P1[8],P1[9],     pw2[2]=PKW(P1,4), pw2[3]=PKW(P1,6), pw2); \
    VRD(3); SBAR(); GAPA(C0=__builtin_amdgcn_mfma_f32_32x32x16_bf16(kf[6],qr[3],C0,0,0,0),   P1[10],P1[11],P1[12],P1[13], pw3[0]=PKW(P1,8), pw3[1]=PKW(P1,10), pw3); \
    VRD(7); SBAR(); GAPA(C1=__builtin_amdgcn_mfma_f32_32x32x16_bf16(kf[7],qr[3],C1,0,0,0),   P1[14],P1[15],0.f,0.f,       pw3[2]=PKW(P1,12),pw3[3]=PKW(P1,14), pw3); \
    l_reg+=sacc; \
    if(GK){DMA_K((t)+3,sl_cur);} if(GV){DMA_V((t)+1,sl_next);} \
    CMASK(C0,C1,t); \
    { float a=MX3(C0[0],C0[1],C1[0]),b=MX3(C0[2],C0[3],C1[1]); a=MX3(a,C1[2],C1[3]); \
      _Pragma("unroll") for(int r=4;r<16;r+=4){a=MX3(a,C0[r],C0[r+1]);b=MX3(b,C0[r+2],C0[r+3]);a=MX3(a,C1[r],C1[r+1]);b=MX3(b,C1[r+2],C1[r+3]);} \
      float rm=__builtin_fmaxf(a,b); { auto rr=__builtin_amdgcn_permlane32_swap(__float_as_uint(rm),__float_as_uint(rm),false,false); rm=__builtin_fmaxf(__uint_as_float(rr[0]),__uint_as_float(rr[1])); } \
      resc=false; \
      if(__builtin_expect(__any(rm>(float)THRL),0)){ const float dl=__builtin_fmaxf(rm,0.f); mhat+=dl; \
        _Pragma("unroll") for(int r=0;r<16;++r){C0[r]-=dl;C1[r]-=dl;} \
        _Pragma("unroll") for(int r=0;r<16;++r)negm[r]=-mhat; asm volatile("":"+v"(negm)); \
        const float f=__builtin_amdgcn_exp2f(-dl); l_reg*=f; if(hi==0)wsf[r32]=f; resc=true; } } \
    SBAR(); \
    GAPB(o[0]=__builtin_amdgcn_mfma_f32_32x32x16_bf16(PAF(0),VFR(0),o[0],0,0,0), C0,0); \
    GAPB(o[1]=__builtin_amdgcn_mfma_f32_32x32x16_bf16(PAF(0),VFR(4),o[1],0,0,0), C0,4); \
    KRD(GL,0); GAPB(o[0]=__builtin_amdgcn_mfma_f32_32x32x16_bf16(PAF(1),VFR(1),o[0],0,0,0), C0,8); \
    KRD(GL,1); GAPB(o[1]=__builtin_amdgcn_mfma_f32_32x32x16_bf16(PAF(1),VFR(5),o[1],0,0,0), C0,12); \
    KRD(GL,2); GAPB(o[0]=__builtin_amdgcn_mfma_f32_32x32x16_bf16(PAF(2),VFR(2),o[0],0,0,0), C1,0); \
    KRD(GL,3); GAPB(o[1]=__builtin_amdgcn_mfma_f32_32x32x16_bf16(PAF(2),VFR(6),o[1],0,0,0), C1,4); \
    GAPB(o[0]=__builtin_amdgcn_mfma_f32_32x32x16_bf16(PAF(3),VFR(3),o[0],0,0,0), C1,8); \
    GAPB(o[1]=__builtin_amdgcn_mfma_f32_32x32x16_bf16(PAF(3),VFR(7),o[1],0,0,0), C1,12); \
    }while(0)
  int t=1;
  #undef CMASK
  #define CMASK(P0,P1,t) do{}while(0)
  for(;t+5<NT;t+=2){
    STEP(pB0,pB1,pA0,pA1,t,true,true,true);     WAIT_BAR(2); RESC(); ROT();
    STEP(pA0,pA1,pB0,pB1,t+1,true,true,true);   WAIT_BAR(2); RESC(); ROT();
  }
  #undef CMASK
  #define CMASK(P0,P1,t) do{int jb_=(t)-(NT-4); if(jb_>=0)cmask(P0,P1,jb_,qrel,hi);}while(0)
  #define ENDW(tt) do{ if((tt)+3<NT){WAIT_BAR(2);} else if((tt)+2<NT){WAIT_BAR(1);} else {WAIT_BAR(0);} }while(0)
  for(;t+1<NT;t+=2){
    STEP(pB0,pB1,pA0,pA1,t,(t+3<NT),(t+1<NT),(t+1<NT));       ENDW(t);   RESC(); ROT();
    STEP(pA0,pA1,pB0,pB1,t+1,(t+4<NT),(t+2<NT),(t+2<NT));     ENDW(t+1); RESC(); ROT();
  }
  STEP(pB0,pB1,pA0,pA1,NT-1,false,false,false); RESC();
  { float sacc=pB0[0]+pB0[1]; _Pragma("unroll") for(int r=2;r<16;++r)sacc+=pB0[r]; _Pragma("unroll") for(int r=0;r<16;++r)sacc+=pB1[r]; l_reg+=sacc;
    pw0=(u32x4){PKW(pB0,0),PKW(pB0,2),PKW(pB0,4),PKW(pB0,6)};pw1=(u32x4){PKW(pB0,8),PKW(pB0,10),PKW(pB0,12),PKW(pB0,14)};pw2=(u32x4){PKW(pB1,0),PKW(pB1,2),PKW(pB1,4),PKW(pB1,6)};pw3=(u32x4){PKW(pB1,8),PKW(pB1,10),PKW(pB1,12),PKW(pB1,14)};
    SBAR(); pv(o,vb0+sl_cur,PAF(0),PAF(1),PAF(2),PAF(3)); }
  #undef PKW
  #undef PAF
  #undef VFR
  #undef PIN
  #undef MX3
  #undef GAPA
  #undef GAPB
  #undef EX
  #undef VRD
  #undef KRD
  #undef STEP
  #undef ENDW
  {auto rr=__builtin_amdgcn_permlane32_swap(__float_as_uint(l_reg),__float_as_uint(l_reg),false,false);l_reg=__uint_as_float(rr[0])+__uint_as_float(rr[1]);}
  if(hi==0)wsf[32+r32]=l_reg;asm volatile("s_waitcnt lgkmcnt(0)":::"memory");
  float rli[16];
  #pragma unroll
  for(int r=0;r<16;++r)rli[r]=__builtin_amdgcn_rcpf(wsf[32+crow(r,hi)]);
  bf16*Ow=O+(rowbase+q0+wid*QBLK)*ODM+oc;
  { bf16*stg=(bf16*)(shm+LDS_OST)+wid*2048;
    #pragma unroll
    for(int r=0;r<16;++r){const int orow=crow(r,hi);
      #pragma unroll
      for(int d0=0;d0<2;++d0)stg[orow*64+d0*32+r32]=__float2bfloat16(o[d0][r]*rli[r]);}
    asm volatile("s_waitcnt lgkmcnt(0)":::"memory");
    #pragma unroll
    for(int i=0;i<4;++i){const int row=i*8+(lane>>3),ch=lane&7; const u32x4 v=*(const u32x4*)(stg+row*64+ch*8); ATTN_STORE16(Ow+(long)row*ODM+ch*8,v);} }
  asm volatile("s_waitcnt lgkmcnt(0)\n\ts_barrier":::"memory");
  #undef DMA_K
  #undef DMA_V
  #undef CMASK
  #undef START
  #undef RESC
  #undef ROT
}
constexpr int ATTN_LDS_BYTES=LDS_BYTES;
#undef SBAR
#undef WAIT_BAR
}
#define GAS __attribute__((address_space(1)))
#define LAS __attribute__((address_space(3)))
typedef unsigned short bf16;
typedef unsigned v4u __attribute__((ext_vector_type(4)));
typedef float f32x4 __attribute__((ext_vector_type(4)));
typedef short bf16x8 __attribute__((ext_vector_type(8)));
typedef GAS unsigned gu32;
typedef GAS unsigned long long gu64;
#define RLX_AGENT __ATOMIC_RELAXED, __HIP_MEMORY_SCOPE_AGENT
#define LDS_WAIT() asm volatile("s_waitcnt lgkmcnt(0)" ::: "memory")
#define VM_WAIT() asm volatile("s_waitcnt vmcnt(0)" ::: "memory")
__device__ __forceinline__ unsigned long long rt() { return __builtin_amdgcn_s_memrealtime(); }
__device__ __forceinline__ unsigned f2bf(float f) { unsigned u = __builtin_bit_cast(unsigned, f); return (u + 0x7fffu + ((u >> 16) & 1u)) >> 16; }
__device__ __forceinline__ unsigned pk2(float lo, float hi) { return f2bf(lo) | (f2bf(hi) << 16); }

#define XB_TMO      128
#define XB_XCNT(j)  (256  + 64 * (j))
#define XB_XSUB(j)  (1280 + 64 * (j))
#define XB_XGEN(j)  (2304 + 64 * (j))
#define XB_TOP      3328
#define XB_TOPGEN   3392
#define XCD_BAR_WORDS 3456
#define XB_SPIN_CAP (1u << 18)

__device__ __forceinline__ unsigned xb_ld(unsigned* p)              { return __hip_atomic_load(p, __ATOMIC_RELAXED, __HIP_MEMORY_SCOPE_AGENT); }
__device__ __forceinline__ unsigned xb_add(unsigned* p, unsigned v) { return __hip_atomic_fetch_add(p, v, __ATOMIC_RELAXED, __HIP_MEMORY_SCOPE_AGENT); }
__device__ __forceinline__ unsigned xb_xcc_id() { return (unsigned)__builtin_amdgcn_s_getreg((3 << 11) | 20) & 0xFu; }
#define XB_SPIN(cond, bar) do { unsigned _sp = 0; while (cond) { __builtin_amdgcn_s_sleep(1); \
    if ((++_sp & 255u) == 0u) { if (xb_ld(&(bar)[XB_TMO])) break; if (_sp > XB_SPIN_CAP) { atomicAdd(&(bar)[XB_TMO], 1u); break; } } } } while (0)

struct XcdBarrier {
    unsigned* bar; unsigned x;
    volatile LAS unsigned* st;
};

__device__ __forceinline__ XcdBarrier xcd_barrier_post(unsigned* bar, volatile LAS unsigned* st) {
    XcdBarrier b; b.bar = bar; b.x = xb_xcc_id(); b.st = st;
    if (threadIdx.x == 0) (void)xb_add(&bar[XB_XCNT(b.x)], 1u);
    return b;
}
__device__ __forceinline__ void xcd_barrier_complete(unsigned* bar, unsigned x, unsigned& nloc, unsigned& nx) {
    const unsigned G = gridDim.x * gridDim.y * gridDim.z;
    unsigned sum, cnt, mine, sp = 0u;
    for (;;) {
        sum = 0u; cnt = 0u; mine = 0u;
#pragma unroll
        for (unsigned j = 0; j < 16; ++j) { const unsigned c = xb_ld(&bar[XB_XCNT(j)]); sum += c; cnt += (c > 0u) ? 1u : 0u; mine = (j == x) ? c : mine; }
        if (sum == G) break;
        __builtin_amdgcn_s_sleep(1);
        if ((++sp & 255u) == 0u) { if (xb_ld(&bar[XB_TMO])) break; if (sp > XB_SPIN_CAP) { atomicAdd(&bar[XB_TMO], 1u); break; } }
    }
    nloc = mine > 0u ? mine : 1u; nx = cnt > 0u ? cnt : 1u;
}

__device__ __forceinline__ void xcd_barrier(const XcdBarrier& b) {
    asm volatile("s_waitcnt vmcnt(0)" ::: "memory");
    __syncthreads();
    if (threadIdx.x == 0) {
        unsigned* bar = b.bar;
        __builtin_amdgcn_s_waitcnt(0);
        unsigned nloc = b.st[0], nx = b.st[1];
        if (nloc == 0u) { xcd_barrier_complete(bar, b.x, nloc, nx); b.st[0] = nloc; b.st[1] = nx; }
        const unsigned old = xb_add(&bar[XB_XSUB(b.x)], 1u);
        const unsigned gen = old / nloc;
        if (old + 1u == (gen + 1u) * nloc) {
            __builtin_amdgcn_fence(__ATOMIC_RELEASE, "agent");
            asm volatile("s_waitcnt vmcnt(0)" ::: "memory");
            const unsigned og = xb_add(&bar[XB_TOP], 1u);
            const unsigned tg = og / nx;
            if (og + 1u == (tg + 1u) * nx) xb_add(&bar[XB_TOPGEN], 1u);
            else XB_SPIN(xb_ld(&bar[XB_TOPGEN]) == tg, bar);
            __builtin_amdgcn_fence(__ATOMIC_ACQUIRE, "agent");
            xb_add(&bar[XB_XGEN(b.x)], 1u);
            asm volatile("s_waitcnt vmcnt(0)" ::: "memory");
        } else {
            XB_SPIN(xb_ld(&bar[XB_XGEN(b.x)]) == gen, bar);
            __builtin_amdgcn_fence(__ATOMIC_ACQUIRE, "agent");
            asm volatile("s_waitcnt vmcnt(0)" ::: "memory");
        }
    }
    __syncthreads();
}

constexpr int RING_OFF = 0, RING_BYTES = 131072;
constexpr int LDSCTL_OFF = RING_BYTES, MISC_OFF = LDSCTL_OFF + 320;
constexpr int LDS_BYTES = 147456;

__device__ __forceinline__ float wave_sum(float v) {
#pragma unroll
    for (int o = 1; o < 64; o <<= 1) v += __shfl_xor(v, o);
    return v;
}
__device__ __forceinline__ float wave_max(float v) {
#pragma unroll
    for (int o = 1; o < 64; o <<= 1) v = fmaxf(v, __shfl_xor(v, o));
    return v;
}
__device__ __forceinline__ float bflo(unsigned w) { return __uint_as_float(w << 16); }
__device__ __forceinline__ float bfhi(unsigned w) { return __uint_as_float(w & 0xffff0000u); }
__device__ __forceinline__ float sigm_(float x) { return __builtin_amdgcn_rcpf(1.f + __expf(-x)); }

__device__ __forceinline__ void p0_transpose_item(const float* W, int K, int N, const float* gk, bf16* WT, int k0, int n0, int orow0, LAS float* scr, int lane) {
#pragma unroll 8
    for (int i = 0; i < 32; ++i) { const int kk = 2 * i + (lane >> 5); float w = W[(size_t)(k0 + kk) * N + n0 + (lane & 31)]; if (gk) w *= gk[k0 + kk]; scr[kk * 33 + (lane & 31)] = w; }
    LDS_WAIT(); asm volatile("" ::: "memory");
    const int c = lane & 7;
#pragma unroll
    for (int j = 0; j < 4; ++j) { const int n = (lane >> 3) + 8 * j; const LAS float* s = scr + (8 * c) * 33 + n;
        v4u o; o.x = pk2(s[0 * 33], s[1 * 33]); o.y = pk2(s[2 * 33], s[3 * 33]); o.z = pk2(s[4 * 33], s[5 * 33]); o.w = pk2(s[6 * 33], s[7 * 33]);
        *(GAS v4u*)(WT + (size_t)(orow0 + n) * K + k0 + 8 * c) = o; }
    LDS_WAIT(); asm volatile("" ::: "memory");
}
__device__ __forceinline__ void sincos_red(float angf, float& c, float& s) {
    const double a = (double)angf, TWO_PI = 6.283185307179586476925;
    const double n = __builtin_rint(a * (1.0 / TWO_PI)); const double r = __builtin_fma(-n, TWO_PI, a), r2 = r * r;
    double sn = 1.0, cs = 1.0;
#pragma unroll
    for (int k = 15; k >= 1; --k) { sn = 1.0 - sn * r2 * (1.0 / (double)((2 * k) * (2 * k + 1))); cs = 1.0 - cs * r2 * (1.0 / (double)((2 * k - 1) * (2 * k))); }
    c = (float)cs; s = (float)(sn * r);
}

template <int NT> __device__ __forceinline__ void block_ln(float (&v)[NT][2], LAS float* red, int tid, int wave, int lane) {
    LAS float* red2 = red + 8 * NT;
#pragma unroll
    for (int t = 0; t < NT; ++t) { const float s = wave_sum(v[t][0] + v[t][1]); if (lane == 0) red[wave * NT + t] = s; }
    __syncthreads();
    if (tid < NT) { float s = 0.f;
#pragma unroll
        for (int w = 0; w < 8; ++w) s += red[w * NT + tid];
        red2[tid] = s * (1.f / 1024.f); }
    __syncthreads();
#pragma unroll
    for (int t = 0; t < NT; ++t) { const float mu = red2[t]; v[t][0] -= mu; v[t][1] -= mu; }
#pragma unroll
    for (int t = 0; t < NT; ++t) { const float s = wave_sum(v[t][0] * v[t][0] + v[t][1] * v[t][1]); if (lane == 0) red[wave * NT + t] = s; }
    __syncthreads();
    if (tid < NT) { float s = 0.f;
#pragma unroll
        for (int w = 0; w < 8; ++w) s += red[w * NT + tid];
        red2[tid] = rsqrtf(s * (1.f / 1024.f) + EPSN); }
    __syncthreads();
#pragma unroll
    for (int t = 0; t < NT; ++t) { const float rs = red2[t]; v[t][0] *= rs; v[t][1] *= rs; }
    __syncthreads();
}

__device__ __forceinline__ void conv_tile(int rowb, int t0, const bf16* Gb, const float* w_dw, const float* b_dw, const float* g_cln, const float* b_cln, bf16* A2, LAS float* red, int tid, int wave, int lane) {
    const int c2 = 2 * tid;
    float w[31][2];
#pragma unroll
    for (int j = 0; j < 31; ++j) { const float2 wv = *(const float2*)(w_dw + j * 1024 + c2); w[j][0] = wv.x; w[j][1] = wv.y; }
    float o[16][2];
#pragma unroll
    for (int t = 0; t < 16; ++t) { o[t][0] = 0.f; o[t][1] = 0.f; }
    const bf16* gp = Gb + (size_t)(rowb + t0 - 30) * 1024 + c2;
#pragma unroll
    for (int ii = 0; ii < 46; ++ii) {
        float x0 = 0.f, x1 = 0.f;
        if (t0 - 30 + ii >= 0) { const unsigned gv = *(const unsigned*)(gp + (size_t)ii * 1024); x0 = bflo(gv); x1 = bfhi(gv); }
#pragma unroll
        for (int tt = (ii > 30 ? ii - 30 : 0); tt <= (ii < 15 ? ii : 15); ++tt) { o[tt][0] += w[ii - tt][0] * x0; o[tt][1] += w[ii - tt][1] * x1; }
        if ((ii & 7) == 7) asm volatile("" ::: "memory");
    }
    { const float2 bv = *(const float2*)(b_dw + c2);
#pragma unroll
      for (int t = 0; t < 16; ++t) { o[t][0] += bv.x; o[t][1] += bv.y; } }
    block_ln<16>(o, red, tid, wave, lane);
    const float2 gv = *(const float2*)(g_cln + c2), bb = *(const float2*)(b_cln + c2);
#pragma unroll
    for (int t = 0; t < 16; ++t) { const float y0 = o[t][0] * gv.x + bb.x, y1 = o[t][1] * gv.y + bb.y;
        *(unsigned*)(A2 + (size_t)(rowb + t0 + t) * 1024 + c2) = pk2(y0 * sigm_(y0), y1 * sigm_(y1)); }
}
__device__ __forceinline__ void conv_sample(const float* state_conv, const float* zs, const float* w_dw, const float* b_dw, const float* g_cln, const float* b_cln, bf16* A2, float* ncs, LAS float* red, int tid, int wave, int lane) {
    const int c2 = 2 * tid;
    float o[8][2];
    const float2 bv = *(const float2*)(b_dw + c2);
#pragma unroll
    for (int b = 0; b < 8; ++b) { o[b][0] = bv.x; o[b][1] = bv.y; }
#pragma unroll 2
    for (int j = 0; j < 30; ++j) { const float2 wv = *(const float2*)(w_dw + j * 1024 + c2);
#pragma unroll
        for (int b = 0; b < 8; ++b) { const float2 hv = *(const float2*)(state_conv + ((size_t)b * 30 + j) * 1024 + c2); o[b][0] += wv.x * hv.x; o[b][1] += wv.y * hv.y;
            if (j >= 1) *(float2*)(ncs + ((size_t)b * 30 + j - 1) * 1024 + c2) = hv; } }
    { const float2 wv = *(const float2*)(w_dw + 30 * 1024 + c2);
#pragma unroll
      for (int b = 0; b < 8; ++b) { const float2 gv = *(const float2*)(zs + (size_t)b * 4096 + 3072 + c2); o[b][0] += wv.x * gv.x; o[b][1] += wv.y * gv.y;
          *(float2*)(ncs + ((size_t)b * 30 + 29) * 1024 + c2) = gv; } }
    block_ln<8>(o, red, tid, wave, lane);
    const float2 gv = *(const float2*)(g_cln + c2), bb = *(const float2*)(b_cln + c2);
#pragma unroll
    for (int b = 0; b < 8; ++b) { const float y0 = o[b][0] * gv.x + bb.x, y1 = o[b][1] * gv.y + bb.y;
        *(unsigned*)(A2 + (size_t)(MPR + b) * 1024 + c2) = pk2(y0 * sigm_(y0), y1 * sigm_(y1)); }
}

__device__ __forceinline__ void decode_unit(int unit, int b, int j0, const float* zs, const float* ck, const float* cv, const int* page_table, float* PART, int wave, int lane) {
    const int h = wave, half = lane >> 5, d4 = lane & 31;
    f32x4 q = *(const f32x4*)(zs + (size_t)b * 4096 + h * 128 + 4 * d4); q = q * C2Q;
    float m0 = -INFINITY, m1 = -INFINITY, l0 = 0.f, l1 = 0.f; f32x4 a0 = {0.f, 0.f, 0.f, 0.f}, a1 = a0;
    for (int jj = 0; jj < 4; ++jj) {
        const int pp = page_table[b * 128 + j0 + jj];
        const float* kp = ck + (size_t)pp * (128 * 1024) + (size_t)half * 1024 + h * 128 + 4 * d4;
        const float* vp = cv + (size_t)pp * (128 * 1024) + (size_t)half * 1024 + h * 128 + 4 * d4;
        for (int t0 = 0; t0 < 128; t0 += 16) {
            f32x4 kk[8], vv[8];
#pragma unroll
            for (int i = 0; i < 8; ++i) { kk[i] = __builtin_nontemporal_load((const f32x4*)(kp + (size_t)(t0 + 2 * i) * 1024)); vv[i] = __builtin_nontemporal_load((const f32x4*)(vp + (size_t)(t0 + 2 * i) * 1024)); }
            float s0[8], s1[8]; float bm0 = -INFINITY, bm1 = -INFINITY;
#pragma unroll
            for (int i = 0; i < 8; ++i) { float s = (kk[i][0] * q[0] + kk[i][1] * q[1]) + (kk[i][2] * q[2] + kk[i][3] * q[3]);
                s += __shfl_xor(s, 1); s += __shfl_xor(s, 2); s += __shfl_xor(s, 4); s += __shfl_xor(s, 8);
                const float so = __shfl_xor(s, 16); s0[i] = (d4 < 16) ? s : so; s1[i] = (d4 < 16) ? so : s; bm0 = fmaxf(bm0, s0[i]); bm1 = fmaxf(bm1, s1[i]); }
            const float mn0 = fmaxf(m0, bm0), mn1 = fmaxf(m1, bm1); const float f0 = __builtin_amdgcn_exp2f(m0 - mn0), f1 = __builtin_amdgcn_exp2f(m1 - mn1);
            m0 = mn0; m1 = mn1; l0 *= f0; l1 *= f1; a0 = a0 * f0; a1 = a1 * f1;
#pragma unroll
            for (int i = 0; i < 8; ++i) { const float p0 = __builtin_amdgcn_exp2f(s0[i] - m0), p1 = __builtin_amdgcn_exp2f(s1[i] - m1); l0 += p0; l1 += p1; a0 = a0 + vv[i] * p0; a1 = a1 + vv[i] * p1; }
        }
    }
    { const float mo0 = __shfl_xor(m0, 32), mo1 = __shfl_xor(m1, 32); const float M0 = fmaxf(m0, mo0), M1 = fmaxf(m1, mo1);
      const float fs0 = __builtin_amdgcn_exp2f(m0 - M0), fo0 = __builtin_amdgcn_exp2f(mo0 - M0), fs1 = __builtin_amdgcn_exp2f(m1 - M1), fo1 = __builtin_amdgcn_exp2f(mo1 - M1);
      l0 = l0 * fs0 + __shfl_xor(l0, 32) * fo0; l1 = l1 * fs1 + __shfl_xor(l1, 32) * fo1;
#pragma unroll
      for (int e = 0; e < 4; ++e) { a0[e] = a0[e] * fs0 + __shfl_xor(a0[e], 32) * fo0; a1[e] = a1[e] * fs1 + __shfl_xor(a1[e], 32) * fo1; }
      m0 = M0; m1 = M1; }
    if (half == 0) { float* p0 = PART + (size_t)((unit * 8 + h) * 2) * 132; float* p1 = p0 + 132;
        *(f32x4*)(p0 + 4 + 4 * d4) = a0; *(f32x4*)(p1 + 4 + 4 * d4) = a1;
        if (d4 == 0) { p0[0] = m0; p0[1] = l0; p1[0] = m1; p1[1] = l1; } }
}

__device__ __forceinline__ float lam_value(const float* lq1, const float* lk1, const float* lq2, const float* lk2, int lane) {
    const float s1 = wave_sum(lq1[lane] * lk1[lane]), s2 = wave_sum(lq2[lane] * lk2[lane]);
    return __expf(s1) - __expf(s2) + 0.2f;
}
__device__ __forceinline__ void combine_row(int r, float lam, const bf16* OM, const bf16* GA, const float* g_subln, bf16* A3, int lane) {
    const int h = lane >> 3, e0 = (lane & 7) * 16;
    const v4u* p0 = (const v4u*)(OM + (size_t)r * 2048 + (h * 2) * 128 + e0); const v4u* p1 = (const v4u*)(OM + (size_t)r * 2048 + (h * 2 + 1) * 128 + e0);
    const v4u* pg = (const v4u*)(GA + (size_t)r * 1024 + h * 128 + e0);
    float o[16]; float ss = 0.f;
#pragma unroll
    for (int j = 0; j < 2; ++j) { const v4u a = p0[j], b = p1[j];
        o[8 * j + 0] = bflo(a.x) - lam * bflo(b.x); o[8 * j + 1] = bfhi(a.x) - lam * bfhi(b.x); o[8 * j + 2] = bflo(a.y) - lam * bflo(b.y); o[8 * j + 3] = bfhi(a.y) - lam * bfhi(b.y);
        o[8 * j + 4] = bflo(a.z) - lam * bflo(b.z); o[8 * j + 5] = bfhi(a.z) - lam * bfhi(b.z); o[8 * j + 6] = bflo(a.w) - lam * bflo(b.w); o[8 * j + 7] = bfhi(a.w) - lam * bfhi(b.w); }
#pragma unroll
    for (int e = 0; e < 16; ++e) ss += o[e] * o[e];
    ss += __shfl_xor(ss, 1); ss += __shfl_xor(ss, 2); ss += __shfl_xor(ss, 4);
    const float rms = rsqrtf(ss * (1.f / 128.f) + EPSN) * 0.8f;
    v4u outv[2];
#pragma unroll
    for (int j = 0; j < 2; ++j) { const v4u g = pg[j]; const f32x4 s0 = *(const f32x4*)(g_subln + e0 + 8 * j), s1 = *(const f32x4*)(g_subln + e0 + 8 * j + 4);
        outv[j].x = pk2(o[8 * j + 0] * rms * s0[0] * bflo(g.x), o[8 * j + 1] * rms * s0[1] * bfhi(g.x)); outv[j].y = pk2(o[8 * j + 2] * rms * s0[2] * bflo(g.y), o[8 * j + 3] * rms * s0[3] * bfhi(g.y));
        outv[j].z = pk2(o[8 * j + 4] * rms * s1[0] * bflo(g.z), o[8 * j + 5] * rms * s1[1] * bfhi(g.z)); outv[j].w = pk2(o[8 * j + 6] * rms * s1[2] * bflo(g.w), o[8 * j + 7] * rms * s1[3] * bfhi(g.w)); }
    v4u* po = (v4u*)(A3 + (size_t)r * 2048 + h * 128 + e0); po[0] = outv[0]; po[1] = outv[1];
}
__device__ __forceinline__ void combine_sample(int b, int h, float lam, const float* PART, const float* zs, const bf16* GA, const float* g_subln, bf16* A3, int lane) {
    float om[2][2];
#pragma unroll
    for (int m = 0; m < 2; ++m) {
        const float* prec = PART + (size_t)(((b * 32 + (lane & 31)) * 8 + h) * 2 + m) * 132;
        float pm = -INFINITY, pl = 0.f; if (lane < 32) { pm = prec[0]; pl = prec[1]; }
        float sd = 0.f;
        if (lane < 16) { const f32x4 qv = *(const f32x4*)(zs + (size_t)b * 4096 + h * 128 + m * 64 + 4 * lane), kv = *(const f32x4*)(zs + (size_t)b * 4096 + 1024 + h * 128 + m * 64 + 4 * lane);
            sd = (qv[0] * kv[0] + qv[1] * kv[1]) + (qv[2] * kv[2] + qv[3] * kv[3]); }
        const float sself = wave_sum(sd) * C2Q;
        const float M = fmaxf(wave_max(pm), sself);
        const float wi = __builtin_amdgcn_exp2f(pm - M), wself = __builtin_amdgcn_exp2f(sself - M);
        const float L = wave_sum(wi * pl) + wself;
        const float2 vs = *(const float2*)(zs + (size_t)b * 4096 + 2048 + h * 128 + 2 * lane);
        float a0 = wself * vs.x, a1 = wself * vs.y;
        for (int i = 0; i < 32; ++i) { const float w = __shfl(wi, i); const float2 av = *(const float2*)(PART + (size_t)(((b * 32 + i) * 8 + h) * 2 + m) * 132 + 4 + 2 * lane); a0 += w * av.x; a1 += w * av.y; }
        const float rl = 1.f / L; om[m][0] = a0 * rl; om[m][1] = a1 * rl;
    }
    const float o0 = om[0][0] - lam * om[1][0], o1 = om[0][1] - lam * om[1][1];
    const float rms = rsqrtf(wave_sum(o0 * o0 + o1 * o1) * (1.f / 128.f) + EPSN) * 0.8f;
    const unsigned g = *(const unsigned*)(GA + (size_t)(MPR + b) * 1024 + h * 128 + 2 * lane); const float2 sv = *(const float2*)(g_subln + 2 * lane);
    *(unsigned*)(A3 + (size_t)(MPR + b) * 2048 + h * 128 + 2 * lane) = pk2(o0 * rms * sv.x * bflo(g), o1 * rms * sv.y * bfhi(g));
}

__device__ __forceinline__ float skinny_unit(const bf16* A, const bf16* Bt, int n0, LAS float* red, int tid, int wave, int lane) {
    const int r = lane & 15, kq = lane >> 4, kb = wave * 256 + 8 * kq;
    f32x4 c0 = {0.f, 0.f, 0.f, 0.f}, c1 = c0;
    const bf16x8 zero = {0, 0, 0, 0, 0, 0, 0, 0};
#pragma unroll
    for (int s = 0; s < 8; ++s) { const int k = kb + 32 * s;
        const bf16x8 a = (r < 8) ? *(const bf16x8*)(A + (size_t)r * 2048 + k) : zero;
        const bf16x8 b0 = *(const bf16x8*)(Bt + (size_t)(n0 + r) * 2048 + k), b1 = *(const bf16x8*)(Bt + (size_t)(n0 + 16 + r) * 2048 + k);
        c0 = __builtin_amdgcn_mfma_f32_16x16x32_bf16(a, b0, c0, 0, 0, 0); c1 = __builtin_amdgcn_mfma_f32_16x16x32_bf16(a, b1, c1, 0, 0, 0); }
    if (kq < 2) {
#pragma unroll
        for (int g = 0; g < 4; ++g) { red[wave * 256 + (kq * 4 + g) * 32 + r] = c0[g]; red[wave * 256 + (kq * 4 + g) * 32 + 16 + r] = c1[g]; } }
    __syncthreads();
    float s = 0.f;
    if (tid < 256) {
#pragma unroll
        for (int w = 0; w < 8; ++w) s += red[w * 256 + tid]; }
    return s;
}

struct Args { const void* in[25]; float* out; unsigned char* ws; float inv[8]; };

#define CAS __attribute__((address_space(4)))
#define PH_BEGIN const CAS Args* ap = (const CAS Args*)__builtin_amdgcn_kernarg_segment_ptr(); asm volatile("" : "+s"(ap)); GAS unsigned char* const wsl = (GAS unsigned char*)ap->ws; float* const out = (float*)(GAS float*)ap->out; (void)out; (void)wsl; int tid_l = threadIdx.x; asm volatile("" : "+v"(tid_l)); const int tid = tid_l, lane = tid & 63; (void)lane
#define INF(i) ((const float*)(const GAS float*)ap->in[i])
#define WSP(T, off) ((T*)(GAS T*)(wsl + (off)))
#define x_prompt INF(0)
#define x_sample INF(1)
#define p_prompt INF(2)
#define p_sample INF(3)
#define cache_k INF(4)
#define cache_v INF(5)
#define state_conv INF(6)
#define page_table ((const int*)(const GAS int*)ap->in[7])
#define w_in INF(8)
#define g_norm INF(9)
#define lq1 INF(10)
#define lk1 INF(11)
#define lq2 INF(12)
#define lk2 INF(13)
#define g_subln INF(14)
#define w_dw INF(15)
#define b_dw INF(16)
#define g_cln INF(17)
#define b_cln INF(18)
#define w_pw INF(19)
#define w_out INF(20)
#define g_ple INF(21)
#define w_pg INF(22)
#define w_ple INF(23)
#define g_final INF(24)
#define WIN WSP(bf16, WS_WIN)
#define WPW WSP(bf16, WS_WPW)
#define WOUT WSP(bf16, WS_WOUT)
#define WPG WSP(bf16, WS_WPG)
#define WPLE WSP(bf16, WS_WPLE)
#define RS0 WSP(float, WS_RS0)
#define SS1 WSP(float, WS_SS1)
#define SS2 WSP(float, WS_SS2)
#define ROPE WSP(float, WS_ROPE)
#define ZS WSP(float, WS_ZS)
#define H1S WSP(float, WS_H1S)
#define SS1S WSP(float, WS_SS1S)
#define SS2S WSP(float, WS_SS2S)
#define PART WSP(float, WS_PART)
#define XB WSP(bf16, WS_XB)
#define PB WSP(bf16, WS_PB)
#define QB WSP(bf16, WS_Q)
#define KB WSP(bf16, WS_K)
#define VB WSP(bf16, WS_V)
#define GA WSP(bf16, WS_GA)
#define GB WSP(bf16, WS_G)
#define GC WSP(bf16, WS_GC)
#define A2 WSP(bf16, WS_A2)
#define OM WSP(bf16, WS_OM)
#define A3 WSP(bf16, WS_A3)
#define PLE WSP(bf16, WS_PLE)
#define H1B WSP(bf16, WS_H1B)

__global__ void __launch_bounds__(NTHR, 2) hymba_fwd(Args args) {
    extern __shared__ __attribute__((aligned(16))) unsigned char lds[];
    LAS unsigned char* L = (LAS unsigned char*)lds;
    volatile LAS unsigned* MISC = (volatile LAS unsigned*)(L + MISC_OFF);
    const int tid = threadIdx.x, lane = tid & 63, wave = __builtin_amdgcn_readfirstlane(tid >> 6);
    const int G = gridDim.x, bx = blockIdx.x, vcu = (G % 8 == 0) ? (bx % 8) * (G / 8) + bx / 8 : bx;
    gu32* ctl = (gu32*)(args.ws + WS_CTL);
    for (int u = tid; u < (LDS_BYTES - LDSCTL_OFF) / 4; u += NTHR) ((LAS unsigned*)(L + LDSCTL_OFF))[u] = 0u;
    __syncthreads();
    XcdBarrier bar = xcd_barrier_post((unsigned*)(ctl + CW_BAR), MISC + 8);

    const int gw = vcu * NWAVES + wave, NGW = G * NWAVES;

#ifndef SKIP_P0
    {
        PH_BEGIN;
        LAS float* scr = (LAS float*)(L + RING_OFF + wave * 16384);
        constexpr int I_IN = (DMOD / 64) * (DIN / 32), I_PW = (1024 / 64) * (1024 / 32), I_OUT = (DMOD / 64) * (DMOD / 32), I_PG = I_OUT, I_PLE = (PLED / 64) * (DMOD / 32);
        constexpr int NITEMS = I_IN + I_PW + I_OUT + I_PG + I_PLE;
        for (int it = gw; it < NITEMS; it += NGW) {
            int r = it;
            if (r < I_IN) { const int nblk = DIN / 32, k0 = 64 * (r / nblk), n0 = 32 * (r % nblk); int orow = n0;
                if (n0 >= 4096 && n0 < 5120) { const int c = n0 - 4096; orow = 4096 + (c >> 7) * 256 + (c & 127); } else if (n0 >= 5120 && n0 < 6144) { const int c = n0 - 5120; orow = 4096 + (c >> 7) * 256 + 128 + (c & 127); }
                p0_transpose_item(w_in, DMOD, DIN, g_norm, WIN, k0, n0, orow, scr, lane); continue; } r -= I_IN;
            if (r < I_PW) { const int nblk = 1024 / 32; p0_transpose_item(w_pw, 1024, 1024, nullptr, WPW, 64 * (r / nblk), 32 * (r % nblk), 32 * (r % nblk), scr, lane); continue; } r -= I_PW;
            if (r < I_OUT) { const int nblk = DMOD / 32; p0_transpose_item(w_out, DMOD, DMOD, nullptr, WOUT, 64 * (r / nblk), 32 * (r % nblk), 32 * (r % nblk), scr, lane); continue; } r -= I_OUT;
            if (r < I_PG) { const int nblk = DMOD / 32; p0_transpose_item(w_pg, DMOD, DMOD, g_ple, WPG, 64 * (r / nblk), 32 * (r % nblk), 32 * (r % nblk), scr, lane); continue; } r -= I_PG;
            { const int nblk = DMOD / 32; p0_transpose_item(w_ple, PLED, DMOD, nullptr, WPLE, 64 * (r / nblk), 32 * (r % nblk), 32 * (r % nblk), scr, lane); }
        }
        for (int r = gw; r < MP; r += NGW) {
            GAS unsigned long long* o8 = (GAS unsigned long long*)(XB + (size_t)r * DMOD) + lane;
            if (r < MV) {
                const GAS f32x4* xr = (const GAS f32x4*)(r < MPR ? x_prompt + (size_t)r * DMOD : x_sample + (size_t)(r - MPR) * DMOD) + lane;
                f32x4 v[8]; float s = 0.f;
#pragma unroll
                for (int j = 0; j < 8; ++j) { v[j] = xr[64 * j]; s += (v[j].x * v[j].x + v[j].y * v[j].y) + (v[j].z * v[j].z + v[j].w * v[j].w); }
                s = wave_sum(s); if (lane == 0) RS0[r] = rsqrtf(s * (1.f / DMOD) + EPSN);
#pragma unroll
                for (int j = 0; j < 8; ++j) o8[64 * j] = (unsigned long long)pk2(v[j].x, v[j].y) | ((unsigned long long)pk2(v[j].z, v[j].w) << 32);
                const f32x4 pv = *((const GAS f32x4*)(r < MPR ? p_prompt + (size_t)r * PLED : p_sample + (size_t)(r - MPR) * PLED) + lane);
                *((GAS unsigned long long*)(PB + (size_t)r * PLED) + lane) = (unsigned long long)pk2(pv.x, pv.y) | ((unsigned long long)pk2(pv.z, pv.w) << 32);
            } else {
#pragma unroll
                for (int j = 0; j < 8; ++j) o8[64 * j] = 0ull;
                *((GAS unsigned long long*)(PB + (size_t)r * PLED) + lane) = 0ull;
                if (lane == 0) RS0[r] = 0.f;
            }
        }
        for (int e = bx * NTHR + tid; e < 2049 * 8; e += G * NTHR) { const int pos = e >> 3, i = e & 7; const float ang = (float)(pos == 2048 ? 16384 : pos) * ap->inv[i];
            float c, s; sincos_red(ang, c, s); ROPE[pos * 16 + i] = c; ROPE[pos * 16 + 8 + i] = s; }
    }
#endif
    xcd_barrier(bar);

#ifndef SKIP_P1
    {
        PH_BEGIN;
        pg8::Gemm g{XB, WIN, MP, DIN, DMOD}; pg8::StaticOrder S; S.init(MP, DIN, G, bx);
        pg8::EpiIn E{(unsigned char*)wsl, out};
        pg8::gemm_phase<pg8::EpiIn, pg8::StaticOrder, PG8_ALIGN, PG8_SP2>(L + RING_OFF, g, S, E);
        pg8::Gemm g2{PB, WPLE, MP, DMOD, PLED}; const int nfull = (33 * 28) % G;
        pg8::TailOrder S2{33, 8, G, bx, (nfull > 0 && nfull < G - 32) ? nfull : 0};
        pg8::EpiBf16<0> E2{PLE, DMOD, nullptr, 0, 0, 1.f};
        pg8::gemm_phase<pg8::EpiBf16<0>, pg8::TailOrder, PG8_ALIGN, PG8_SP2>(L + RING_OFF, g2, S2, E2);
    }
#endif
    xcd_barrier(bar);

#ifndef SKIP_P2
    {
        PH_BEGIN;
        LAS float* red = (LAS float*)(L + RING_OFF);
#ifndef SKIP_CONV
        for (int t = bx; t < MPR / 16; t += G) conv_tile((t >> 7) * SEQL, (t & 127) * 16, GB, w_dw, b_dw, g_cln, b_cln, A2, red, tid, wave, lane);
        if (bx == G - 1) conv_sample(state_conv, ZS, w_dw, b_dw, g_cln, b_cln, A2, out + ONCS, red, tid, wave, lane);
#endif
        __syncthreads();
#ifndef SKIP_ATTN
        if (vcu < 256) {
            const int v = vcu, x = v >> 2, b = x >> 4, h = (x >> 1) & 7, m = x & 1, s = v & 3;
#pragma unroll 1
            for (int i = 0; i < 4; ++i) { const int qb = (i < 2) ? s : 7 - s, vh = i & 1;
                attn_body::attn_unit<8>(b, h * 128 + m * 64, h * 128 + m * 64, h * 128 + vh * 64, (h * 2 + m) * 128 + vh * 64, qb,
                                        (const attn_body::bf16*)QB, (const attn_body::bf16*)KB, (const attn_body::bf16*)VB, (attn_body::bf16*)OM, (char*)lds + RING_OFF); }
        }
#endif
#ifndef SKIP_DEC
        for (int u = vcu; u < 256; u += G) decode_unit(u, u >> 5, (u & 31) * 4, ZS, cache_k, cache_v, page_table, PART, wave, lane);
#endif
    }
#endif
    xcd_barrier(bar);

#ifndef SKIP_P3
    {
        PH_BEGIN;
        pg8::Gemm g{A2, WPW, MP, 1024, 1024}; pg8::StaticOrder S; S.init(MP, 1024, G, bx);
        pg8::EpiPw E{GC, A3};
        pg8::gemm_phase<pg8::EpiPw, pg8::StaticOrder, PG8_ALIGN, PG8_SP2>(L + RING_OFF, g, S, E);
        const int c0 = (132 < G - 16) ? 132 : 0;
        if (bx >= c0) {
            const float lam = lam_value(lq1, lk1, lq2, lk2, lane);
            const int nw = (G - c0) * NWAVES, w0 = (bx - c0) * NWAVES + wave;
            for (int r = w0; r < MPR; r += nw) combine_row(r, lam, OM, GA, g_subln, A3, lane);
            if (w0 < 64) combine_sample(w0 >> 3, w0 & 7, lam, PART, ZS, GA, g_subln, A3, lane);
        }
    }
#endif
    xcd_barrier(bar);

#ifndef SKIP_P4
    {
        PH_BEGIN;
        pg8::Gemm g{A3, WOUT, MPR, DMOD, DMOD}; pg8::StaticOrder S; S.init(MPR, DMOD, G, bx);
        pg8::EpiOut E{x_prompt, out + OY, H1B, SS1};
        pg8::gemm_phase<pg8::EpiOut, pg8::StaticOrder, false, PG8_SP2>(L + RING_OFF, g, S, E);
        __syncthreads();
        LAS float* red = (LAS float*)(L + RING_OFF + 8192);
        for (int mu = bx; mu < 64; mu += G) {
            const int n0 = mu * 32; const float acc = skinny_unit(A3 + (size_t)MPR * DMOD, WOUT, n0, red, tid, wave, lane);
            if (tid < 256) { const int row = tid >> 5, col = n0 + (tid & 31); const float v = x_sample[row * DMOD + col] + acc;
                H1S[row * DMOD + col] = v; H1B[(size_t)(MPR + row) * DMOD + col] = (bf16)f2bf(v);
                float s = v * v; s += __shfl_xor(s, 1); s += __shfl_xor(s, 2); s += __shfl_xor(s, 4); s += __shfl_xor(s, 8); s += __shfl_xor(s, 16);
                if ((tid & 31) == 0) SS1S[row * 64 + mu] = s; }
            __syncthreads();
        }
    }
#endif
    xcd_barrier(bar);

#ifndef SKIP_P5
    {
        PH_BEGIN;
        pg8::Gemm g{H1B, WPG, MPR, DMOD, DMOD}; pg8::StaticOrder S; S.init(MPR, DMOD, G, bx);
        pg8::EpiPg E{SS1, PLE, out + OY, SS2};
        pg8::gemm_phase<pg8::EpiPg, pg8::StaticOrder, false, PG8_SP2>(L + RING_OFF, g, S, E);
        __syncthreads();
        LAS float* red = (LAS float*)(L + RING_OFF + 8192);
        for (int mu = bx; mu < 64; mu += G) {
            const int n0 = mu * 32; const float acc = skinny_unit(H1B + (size_t)MPR * DMOD, WPG, n0, red, tid, wave, lane);
            if (tid < 256) { const int row = tid >> 5, col = n0 + (tid & 31);
                float ssum = SS1S[row * 64 + (tid & 31)] + SS1S[row * 64 + 32 + (tid & 31)];
                ssum += __shfl_xor(ssum, 1); ssum += __shfl_xor(ssum, 2); ssum += __shfl_xor(ssum, 4); ssum += __shfl_xor(ssum, 8); ssum += __shfl_xor(ssum, 16);
                const float rsv = rsqrtf(ssum * (1.f / DMOD) + EPSN);
                const float pl = bflo((unsigned)PLE[(size_t)(MPR + row) * DMOD + col]);
                const float v = H1S[row * DMOD + col] + sigm_(acc * rsv) * pl;
                out[OYS + row * DMOD + col] = v;
                float s = v * v; s += __shfl_xor(s, 1); s += __shfl_xor(s, 2); s += __shfl_xor(s, 4); s += __shfl_xor(s, 8); s += __shfl_xor(s, 16);
                if ((tid & 31) == 0) SS2S[row * 64 + mu] = s; }
            __syncthreads();
        }
    }
#endif
    xcd_barrier(bar);

#ifndef SKIP_P6
    { PH_BEGIN;
    for (int r = gw; r < MV; r += NGW) {
        float sv; GAS f32x4* hp;
        if (r < MPR) { sv = (lane < 8) ? SS2[(size_t)r * 8 + lane] : 0.f; hp = (GAS f32x4*)(out + OY + (size_t)r * DMOD) + lane; }
        else { sv = SS2S[(r - MPR) * 64 + lane]; hp = (GAS f32x4*)(out + OYS + (size_t)(r - MPR) * DMOD) + lane; }
        const float rsv = rsqrtf(wave_sum(sv) * (1.f / DMOD) + EPSN);
#pragma unroll
        for (int j = 0; j < 8; ++j) { const f32x4 g = *((const GAS f32x4*)g_final + lane + 64 * j); f32x4 v = hp[64 * j]; v = v * rsv * g; hp[64 * j] = v; }
    }
    }
#endif
}

extern "C" void kernel_launch(void* const* d_in, const int* in_sizes, int n_in, void* d_out, int out_size, void* d_ws, size_t ws_size, hipStream_t stream) {
    static int grid = 0;
    if (grid == 0) {
        if (n_in != 25 || (size_t)out_size != OUT_TOTAL || ws_size < WS_END) { fprintf(stderr, "kernel_launch: unexpected shapes (n_in %d, out %d, ws %zu); nothing launched\n", n_in, out_size, ws_size); grid = -1; return; }
        if (hipFuncSetAttribute((const void*)hymba_fwd, hipFuncAttributeMaxDynamicSharedMemorySize, LDS_BYTES) != hipSuccess) { fprintf(stderr, "kernel_launch: hipFuncSetAttribute failed\n"); grid = -1; return; }
        int per_cu = 0;
        if (hipOccupancyMaxActiveBlocksPerMultiprocessor(&per_cu, (const void*)hymba_fwd, NTHR, LDS_BYTES) != hipSuccess || per_cu < 1)
            fprintf(stderr, "kernel_launch: note: occupancy query reports %d workgroups per CU\n", per_cu);
        (void)hipGetLastError();
        grid = 256;
    }
    if (grid < 0) return;
    if (hipMemsetAsync((char*)d_ws + WS_CTL, 0, CTL_ZERO_BYTES, stream) != hipSuccess) { fprintf(stderr, "kernel_launch: hipMemsetAsync failed\n"); return; }
    Args a{};
    for (int i = 0; i < 25; ++i) a.in[i] = d_in[i];
    a.out = (float*)d_out; a.ws = (unsigned char*)d_ws;
    for (int i = 0; i < 8; ++i) a.inv[i] = (float)pow(500000.0, -(double)(2 * i) / 16.0);
    hipLaunchKernelGGL(hymba_fwd, dim3(grid), dim3(NTHR), LDS_BYTES, stream, a);
    const hipError_t le = hipPeekAtLastError();
    if (le != hipSuccess) fprintf(stderr, "kernel_launch: launch failed: %s\n", hipGetErrorName(le));
}
```

```cpp
#include <hip/hip_runtime.h>
#include <hip/hip_bf16.h>
#include <cstdio>
#include <cstdint>
#include <cmath>
constexpr int NWAVES = 8, NTHR = NWAVES * 64;
constexpr int MPR = 8192, MV = 8200, MP = 8448;
constexpr int DMOD = 2048, DIN = 7168, AWD = 1024, PLED = 256, SEQL = 2048;
constexpr float EPSN = 1e-6f;
constexpr float C2Q = 0.125f * 1.4426950408889634f;
constexpr size_t OY = 0, OYS = 16777216, ONK = 16793600, ONV = 25182208, ONC = 33570816, ONKS = 33693696, ONVS = 33701888, ONCS = 33710080, OUT_TOTAL = 33955840;
constexpr size_t MiB = 1u << 20;
constexpr size_t WS_CTL = 0, CTL_ZERO_BYTES = 1 * MiB;
constexpr size_t WS_WIN = 2 * MiB, WS_WPW = 30 * MiB, WS_WOUT = 32 * MiB, WS_WPG = 40 * MiB, WS_WPLE = 48 * MiB;
constexpr size_t WS_RS0 = 49 * MiB, WS_SS1 = WS_RS0 + 64 * 1024, WS_SS2 = WS_SS1 + 512 * 1024, WS_ROPE = WS_SS2 + 512 * 1024, WS_ZS = WS_ROPE + 256 * 1024,
                 WS_H1S = WS_ZS + 128 * 1024, WS_SS1S = WS_H1S + 64 * 1024, WS_SS2S = WS_SS1S + 4096, WS_PART = 52 * MiB;
constexpr size_t WS_XB = 64 * MiB, WS_PB = 97 * MiB, WS_Q = 102 * MiB, WS_K = 119 * MiB, WS_V = 136 * MiB, WS_GA = 153 * MiB, WS_G = 170 * MiB, WS_GC = 187 * MiB, WS_A2 = 204 * MiB,
                 WS_OM = 221 * MiB, WS_A3 = 253 * MiB, WS_PLE = 286 * MiB, WS_H1B = 319 * MiB, WS_END = 352 * MiB;
constexpr int CW_TMO = 0, CW_BAR = 4096;
namespace pg8 {
#define PG8_LAS __attribute__((address_space(3)))
typedef unsigned short bf16_t;
typedef short bf16x8 __attribute__((ext_vector_type(8)));
typedef float f32x4 __attribute__((ext_vector_type(4)));
typedef unsigned u32x4 __attribute__((ext_vector_type(4)));
constexpr int BM = 256, BK = 64, HALF = 128, HTB = HALF * BK * 2  , STAGE_BYTES = 8 * HTB, NXCD = 8, WGM = 8;

__host__ __device__ __forceinline__ int lds_byte(int r, int c) { const int st = (r >> 4) * 2 + (c >> 5), rr = r & 15, cc = c & 31, ob = rr * 64 + cc * 2; return st * 1024 + (ob ^ (((ob >> 9) & 1) << 5)); }
__host__ __device__ __forceinline__ void stage_rc(int b, int& R, int& C) { const int st = b / 1024, sb = b % 1024, swz = sb ^ (((sb >> 9) & 1) << 5); R = (st >> 1) * 16 + swz / 64; C = (st & 1) * 32 + (swz % 64) / 2; }
__host__ __device__ __forceinline__ int perm32(int rho) { const int n = rho >> 4, i = rho & 15; return 8 * (i >> 2) + 4 * n + (i & 3); }

struct Unit { int pm, pn; };
struct Gemm { const bf16_t* A; const bf16_t* Bt; int M, N, K; };

struct StaticOrder {
    int nM, nN, nwg, G, c;
    __host__ __device__ void init(int M, int N, int G_, int c_) { nM = M / BM; nN = N / BM; nwg = nM * nN; G = G_; c = c_; }
    __host__ __device__ bool next(int i, Unit& u) const {
        const long L = (long)i * G + c; if (L >= nwg) return false;
        int wgid = (int)L; { const int q = nwg / NXCD, r = nwg % NXCD, xcd = wgid % NXCD, off = wgid / NXCD; wgid = (xcd < r ? xcd * (q + 1) : r * (q + 1) + (xcd - r) * q) + off; }
        const int nig = WGM * nN, gid = wgid / nig, fm = gid * WGM, gsz = (nM - fm) < WGM ? (nM - fm) : WGM;
        u.pm = fm + ((wgid % nig) % gsz); u.pn = (wgid % nig) / gsz; return true;
    }
    __device__ __forceinline__ void a_ready(const Unit&) const {}
    __device__ __forceinline__ void done(const Unit&) const {}
};

__device__ __forceinline__ unsigned cvt_pk_bf16(float lo, float hi) { unsigned r; asm volatile("v_cvt_pk_bf16_f32 %0, %1, %2" : "=v"(r) : "v"(lo), "v"(hi)); return r; }
typedef float f32x2 __attribute__((ext_vector_type(2)));
__device__ __forceinline__ f32x2 gelu_pk(f32x2 v) {
    const f32x2 av = __builtin_elementwise_abs(v), d = av * 0.2316418882f + 1.0f;
    f32x2 t; t.x = __builtin_amdgcn_rcpf(d.x); t.y = __builtin_amdgcn_rcpf(d.y);
    f32x2 q = t * 0.5307027145f + (-0.7265760135f); q = q * t + 0.7107068705f; q = q * t + (-0.142248368f); q = q * t + 0.127414796f; q = q * t;
    const f32x2 s = (v * v) * (-0.72134752044f);
    f32x2 e; e.x = __builtin_amdgcn_exp2f(s.x); e.y = __builtin_amdgcn_exp2f(s.y);
    const f32x2 m = v * (q * e), r = v - m;
    f32x2 o; o.x = v.x < 0.f ? m.x : r.x; o.y = v.y < 0.f ? m.y : r.y; return o;
}

template <int ACT  > struct EpiBf16 {
    static constexpr bool PERM = true, AFTER_DRAIN = false; static_assert(ACT == 0 || ACT == 1, "EpiBf16: ACT is 0 (none) or 1 (gelu_pk)");
    bf16_t* O; int ldc; const float* bias; int split_cols; size_t split_stride; float scale0;
    __device__ __forceinline__ void operator()(const f32x4 (&acc)[2][2][4][2], const Unit& u, int wr, int wc, int fr, int fq) const {
        const int row0 = u.pm * BM + wr * 64 + fr; int colt = u.pn * BM; bf16_t* base = O;
        float sc = 1.f; if (split_cols) { const int t = colt / split_cols; base += (size_t)t * split_stride; colt -= t * split_cols; if (t == 0) sc = scale0; }
        const int col0 = colt + wc * 32 + 8 * fq, bcol0 = u.pn * BM + wc * 32 + 8 * fq;
        f32x4 bv[2][2];
#pragma unroll
        for (int bj = 0; bj < 2; ++bj)
#pragma unroll
            for (int n = 0; n < 2; ++n) bv[bj][n] = bias ? *(const f32x4*)(bias + bcol0 + bj * HALF + 4 * n) : (f32x4){0.f, 0.f, 0.f, 0.f};
#pragma unroll
        for (int ai = 0; ai < 2; ++ai)
#pragma unroll
            for (int m = 0; m < 4; ++m) { bf16_t* rowp = base + (size_t)(row0 + ai * HALF + m * 16) * ldc + col0;
#pragma unroll
                for (int bj = 0; bj < 2; ++bj) { f32x4 v0 = acc[ai][bj][m][0] + bv[bj][0], v1 = acc[ai][bj][m][1] + bv[bj][1];
                    if (ACT == 1) { f32x2 a = gelu_pk((f32x2){v0[0], v0[1]}), b = gelu_pk((f32x2){v0[2], v0[3]}), c = gelu_pk((f32x2){v1[0], v1[1]}), d = gelu_pk((f32x2){v1[2], v1[3]});
                        v0 = (f32x4){a.x, a.y, b.x, b.y}; v1 = (f32x4){c.x, c.y, d.x, d.y}; }
                    v0 = v0 * sc; v1 = v1 * sc; u32x4 w; w.x = cvt_pk_bf16(v0[0], v0[1]); w.y = cvt_pk_bf16(v0[2], v0[3]); w.z = cvt_pk_bf16(v1[0], v1[1]); w.w = cvt_pk_bf16(v1[2], v1[3]);
                    *(u32x4*)(rowp + bj * HALF) = w; } }
    }
};

constexpr int E_MV = 8200;
constexpr float E_C2 = 0.125f * 1.4426950408889634f;
__device__ __forceinline__ float sigm(float x) { return __builtin_amdgcn_rcpf(1.f + __expf(-x)); }
__device__ __forceinline__ float silu(float x) { return x * sigm(x); }
__device__ __forceinline__ u32x4 pack8(const f32x4 a, const f32x4 b) { u32x4 w; w.x = cvt_pk_bf16(a[0], a[1]); w.y = cvt_pk_bf16(a[2], a[3]); w.z = cvt_pk_bf16(b[0], b[1]); w.w = cvt_pk_bf16(b[2], b[3]); return w; }
__device__ __forceinline__ void unpack8(const u32x4 w, f32x4& a, f32x4& b) {
    a[0] = __uint_as_float(w.x << 16); a[1] = __uint_as_float(w.x & 0xffff0000u); a[2] = __uint_as_float(w.y << 16); a[3] = __uint_as_float(w.y & 0xffff0000u);
    b[0] = __uint_as_float(w.z << 16); b[1] = __uint_as_float(w.z & 0xffff0000u); b[2] = __uint_as_float(w.w << 16); b[3] = __uint_as_float(w.w & 0xffff0000u); }

struct EpiIn {
    static constexpr bool PERM = true, AFTER_DRAIN = false;
    unsigned char* ws; float* out;
    __device__ __forceinline__ void operator()(const f32x4 (&acc)[2][2][4][2], const Unit& u, int wr, int wc, int fr_in, int fq_in) const {
        int fr = fr_in, fq = fq_in; asm volatile("" : "+v"(fr), "+v"(fq));
        const int pn = u.pn; const bool samp = (u.pm == 32);
        const float* rs = (const float*)(ws + WS_RS0); const float* rope = (const float*)(ws + WS_ROPE); float* zs = (float*)(ws + WS_ZS);
        bf16_t* Q = (bf16_t*)(ws + WS_Q); bf16_t* K = (bf16_t*)(ws + WS_K); bf16_t* V = (bf16_t*)(ws + WS_V); bf16_t* GA = (bf16_t*)(ws + WS_GA); bf16_t* G = (bf16_t*)(ws + WS_G); bf16_t* GC = (bf16_t*)(ws + WS_GC);
        float* nk = out + ONK; float* nv = out + ONV; float* nconv = out + ONC; float* nks = out + ONKS; float* nvs = out + ONVS;
        const int rbase = u.pm * BM + wr * 64 + fr, cl = wc * 32 + 8 * fq;
        if (pn < 8) {
            const bool isk = pn >= 4; const int colt = (pn & 3) * 256; const bool rot = (wc & 1) == 0;
#pragma unroll
            for (int ai = 0; ai < 2; ++ai)
#pragma unroll
                for (int m = 0; m < 4; ++m) {
                    const int row = rbase + ai * HALF + m * 16; const float rsv = rs[row]; const int pos = samp ? 2048 : (row & 2047);
                    f32x4 c0 = {1.f, 1.f, 1.f, 1.f}, c1 = c0, s0 = {0.f, 0.f, 0.f, 0.f}, s1 = s0;
                    if (rot) { const f32x4* rp = (const f32x4*)(rope + pos * 16); c0 = rp[0]; c1 = rp[1]; s0 = rp[2]; s1 = rp[3]; }
#pragma unroll
                    for (int bj = 0; bj < 2; ++bj) {
                        f32x4 v0 = acc[ai][bj][m][0] * rsv, v1 = acc[ai][bj][m][1] * rsv;
                        if (rot) { f32x4 p0, p1;
#pragma unroll
                            for (int e = 0; e < 4; ++e) { p0[e] = __shfl_xor(v0[e], 16); p1[e] = __shfl_xor(v1[e], 16); }
                            if (fq < 2) { const float sg = fq == 0 ? -1.f : 1.f; v0 = v0 * c0 + (p0 * s0) * sg; v1 = v1 * c1 + (p1 * s1) * sg; } }
                        const int col = colt + bj * HALF + cl;
                        if (row < E_MV) {
                            if (!isk) { *(u32x4*)(Q + (size_t)row * 1024 + col) = pack8(v0 * E_C2, v1 * E_C2);
                                if (samp) { float* z = zs + (size_t)(row - 8192) * 4096 + col; *(f32x4*)z = v0; *(f32x4*)(z + 4) = v1; } }
                            else { *(u32x4*)(K + (size_t)row * 1024 + col) = pack8(v0, v1);
                                float* o = samp ? nks + (size_t)(row - 8192) * 1024 + col : nk + (size_t)row * 1024 + col; *(f32x4*)o = v0; *(f32x4*)(o + 4) = v1;
                                if (samp) { float* z = zs + (size_t)(row - 8192) * 4096 + 1024 + col; *(f32x4*)z = v0; *(f32x4*)(z + 4) = v1; } }
                        }
                    }
                }
        } else if (pn < 12) {
            const int colt = (pn - 8) * 256;
#pragma unroll
            for (int ai = 0; ai < 2; ++ai)
#pragma unroll
                for (int m = 0; m < 4; ++m) {
                    const int row = rbase + ai * HALF + m * 16; const float rsv = rs[row];
#pragma unroll
                    for (int bj = 0; bj < 2; ++bj) {
                        const f32x4 v0 = acc[ai][bj][m][0] * rsv, v1 = acc[ai][bj][m][1] * rsv; const int col = colt + bj * HALF + cl;
                        if (row < E_MV) { *(u32x4*)(V + (size_t)row * 1024 + col) = pack8(v0, v1);
                            float* o = samp ? nvs + (size_t)(row - 8192) * 1024 + col : nv + (size_t)row * 1024 + col; *(f32x4*)o = v0; *(f32x4*)(o + 4) = v1;
                            if (samp) { float* z = zs + (size_t)(row - 8192) * 4096 + 2048 + col; *(f32x4*)z = v0; *(f32x4*)(z + 4) = v1; } }
                    }
                }
        } else if (pn < 16 || pn >= 24) {
            bf16_t* O = pn < 16 ? GA : GC; const int colt = (pn < 16 ? pn - 12 : pn - 24) * 256;
#pragma unroll
            for (int ai = 0; ai < 2; ++ai)
#pragma unroll
                for (int m = 0; m < 4; ++m) {
                    const int row = rbase + ai * HALF + m * 16; const float rsv = rs[row];
#pragma unroll
                    for (int bj = 0; bj < 2; ++bj) {
                        f32x4 v0 = acc[ai][bj][m][0] * rsv, v1 = acc[ai][bj][m][1] * rsv;
#pragma unroll
                        for (int e = 0; e < 4; ++e) { v0[e] = silu(v0[e]); v1[e] = silu(v1[e]); }
                        if (row < E_MV) *(u32x4*)(O + (size_t)row * 1024 + colt + bj * HALF + cl) = pack8(v0, v1);
                    }
                }
        } else {
            const int col = (pn - 16) * 128 + cl;
#pragma unroll
            for (int ai = 0; ai < 2; ++ai)
#pragma unroll
                for (int m = 0; m < 4; ++m) {
                    const int row = rbase + ai * HALF + m * 16; const float rsv = rs[row];
                    f32x4 g0, g1;
#pragma unroll
                    for (int e = 0; e < 4; ++e) { g0[e] = (acc[ai][0][m][0][e] * rsv) * sigm(acc[ai][1][m][0][e] * rsv); g1[e] = (acc[ai][0][m][1][e] * rsv) * sigm(acc[ai][1][m][1][e] * rsv); }
                    if (row < E_MV) { *(u32x4*)(G + (size_t)row * 1024 + col) = pack8(g0, g1);
                        if (samp) { float* z = zs + (size_t)(row - 8192) * 4096 + 3072 + col; *(f32x4*)z = g0; *(f32x4*)(z + 4) = g1; }
                        else { const int t = row & 2047; if (t >= 2018) { float* o = nconv + ((size_t)(row >> 11) * 30 + (t - 2018)) * 1024 + col; *(f32x4*)o = g0; *(f32x4*)(o + 4) = g1; } } }
                }
        }
    }
};

struct EpiPw {
    static constexpr bool PERM = true, AFTER_DRAIN = false;
    const bf16_t* GC; bf16_t* A3;
    __device__ __forceinline__ void operator()(const f32x4 (&acc)[2][2][4][2], const Unit& u, int wr, int wc, int fr, int fq) const {
        const int rbase = u.pm * BM + wr * 64 + fr, cb = u.pn * BM + wc * 32 + 8 * fq;
#pragma unroll
        for (int ai = 0; ai < 2; ++ai)
#pragma unroll
            for (int m = 0; m < 4; ++m) {
                const int row = rbase + ai * HALF + m * 16;
#pragma unroll
                for (int bj = 0; bj < 2; ++bj) { const int col = cb + bj * HALF; f32x4 g0, g1; unpack8(*(const u32x4*)(GC + (size_t)row * 1024 + col), g0, g1);
                    *(u32x4*)(A3 + (size_t)row * 2048 + 1024 + col) = pack8(acc[ai][bj][m][0] * g0, acc[ai][bj][m][1] * g1); }
            }
    }
};

struct EpiOut {
    static constexpr bool PERM = true, AFTER_DRAIN = true;
    const float* x; bf16_t* h1b; float* ss;
    __device__ __forceinline__ void fused(f32x4 (&acc)[2][2][4][2], const Unit& u, int wr, int wc, int fr, int fq, PG8_LAS unsigned char* lds, int wid, int lane) const {
        PG8_LAS float* P = (PG8_LAS float*)lds;
        const int rbase = u.pm * BM + wr * 64 + fr, cb = u.pn * BM + wc * 32 + 8 * fq;
#pragma unroll
        for (int ai = 0; ai < 2; ++ai)
#pragma unroll
            for (int m = 0; m < 4; ++m) {
                const int row = rbase + ai * HALF + m * 16; float s = 0.f;
#pragma unroll
                for (int bj = 0; bj < 2; ++bj) { const size_t off = (size_t)row * 2048 + cb + bj * HALF;
                    const f32x4 v0 = acc[ai][bj][m][0] + *(const f32x4*)(x + off), v1 = acc[ai][bj][m][1] + *(const f32x4*)(x + off + 4);
                    s += (v0[0] * v0[0] + v0[1] * v0[1]) + (v0[2] * v0[2] + v0[3] * v0[3]) + (v1[0] * v1[0] + v1[1] * v1[1]) + (v1[2] * v1[2] + v1[3] * v1[3]);
                    *(u32x4*)(h1b + off) = pack8(v0, v1); }
                s += __shfl_xor(s, 16); s += __shfl_xor(s, 32);
                if (fq == 0) P[(ai * HALF + wr * 64 + m * 16 + fr) * 4 + wc] = s;
            }
        asm volatile("s_waitcnt lgkmcnt(0)" ::: "memory"); __builtin_amdgcn_s_barrier(); asm volatile("" ::: "memory");
        const int t = wid * 64 + lane;
        if (t < 256) ss[(size_t)(u.pm * BM + t) * 8 + u.pn] = (P[t * 4] + P[t * 4 + 1]) + (P[t * 4 + 2] + P[t * 4 + 3]);
    }
};

struct EpiPg {
    static constexpr bool PERM = true, AFTER_DRAIN = true;
    const float* ss1; const bf16_t* ple; const bf16_t* h1b; float* h; float* ss2;
    __device__ __forceinline__ void fused(f32x4 (&acc)[2][2][4][2], const Unit& u, int wr, int wc, int fr, int fq, PG8_LAS unsigned char* lds, int wid, int lane) const {
        PG8_LAS float* P = (PG8_LAS float*)lds; PG8_LAS float* RS = (PG8_LAS float*)(lds + 4096);
        const int t = wid * 64 + lane;
        if (t < 256) { const f32x4* sp = (const f32x4*)(ss1 + (size_t)(u.pm * BM + t) * 8); const f32x4 a = sp[0], b = sp[1];
            RS[t] = rsqrtf(((a[0] + a[1]) + (a[2] + a[3]) + (b[0] + b[1]) + (b[2] + b[3])) * (1.f / 2048.f) + 1e-6f); }
        asm volatile("s_waitcnt lgkmcnt(0)" ::: "memory"); __builtin_amdgcn_s_barrier(); asm volatile("" ::: "memory");
        const int rbase = u.pm * BM + wr * 64 + fr, cb = u.pn * BM + wc * 32 + 8 * fq;
#pragma unroll
        for (int ai = 0; ai < 2; ++ai)
#pragma unroll
            for (int m = 0; m < 4; ++m) {
                const int rl = ai * HALF + wr * 64 + m * 16 + fr, row = rbase + ai * HALF + m * 16; const float rsv = RS[rl]; float s = 0.f;
#pragma unroll
                for (int bj = 0; bj < 2; ++bj) { const size_t off = (size_t)row * 2048 + cb + bj * HALF;
                    f32x4 p0, p1; unpack8(*(const u32x4*)(ple + off), p0, p1);
                    f32x4 v0, v1; unpack8(*(const u32x4*)(h1b + off), v0, v1);
#pragma unroll
                    for (int e = 0; e < 4; ++e) { v0[e] += sigm(acc[ai][bj][m][0][e] * rsv) * p0[e]; v1[e] += sigm(acc[ai][bj][m][1][e] * rsv) * p1[e]; }
                    s += (v0[0] * v0[0] + v0[1] * v0[1]) + (v0[2] * v0[2] + v0[3] * v0[3]) + (v1[0] * v1[0] + v1[1] * v1[1]) + (v1[2] * v1[2] + v1[3] * v1[3]);
                    *(f32x4*)(h + off) = v0; *(f32x4*)(h + off + 4) = v1; }
                s += __shfl_xor(s, 16); s += __shfl_xor(s, 32);
                if (fq == 0) P[rl * 4 + wc] = s;
            }
        asm volatile("s_waitcnt lgkmcnt(0)" ::: "memory"); __builtin_amdgcn_s_barrier(); asm volatile("" ::: "memory");
        if (t < 256) ss2[(size_t)(u.pm * BM + t) * 8 + u.pn] = (P[t * 4] + P[t * 4 + 1]) + (P[t * 4 + 2] + P[t * 4 + 3]);
    }
};
struct TailOrder {
    int nM, nN, G, c, c0;
    __device__ __forceinline__ bool next(int i, Unit& u) const { if (c < c0) return false; const int L = i * (G - c0) + (c - c0); if (L >= nM * nN) return false; u.pm = L % nM; u.pn = L / nM; return true; }
    __device__ __forceinline__ void a_ready(const Unit&) const {}
    __device__ __forceinline__ void done(const Unit&) const {}
};
template <class Epi, class Sched, bool ALIGN_EPI = false, bool SP2 = false>
__device__ __forceinline__ void gemm_phase(PG8_LAS unsigned char* lds, const Gemm g, const Sched& S, const Epi& E) {
    int tid_l = threadIdx.x; asm volatile("" : "+v"(tid_l));
    const int tid = tid_l, wid = __builtin_amdgcn_readfirstlane(tid >> 6), lane = tid & 63, wr = wid >> 2, wc = wid & 3, fr = lane & 15, fq = lane >> 4;
    const int K = g.K, nt = K / BK;
    unsigned voffA[2], voffB[2];
#pragma unroll
    for (int i = 0; i < 2; ++i) { int R, C; stage_rc(tid * 16 + i * 8192, R, C); const int Rb = Epi::PERM ? ((R & ~31) + perm32(R & 31)) : R;
        voffA[i] = (unsigned)(R * K + C) * 2u; voffB[i] = (unsigned)(Rb * K + C) * 2u; }
    const size_t kstep = (size_t)(BK * 2);
    const size_t hstep = (size_t)HALF * K * 2;
    const size_t tstep = 2 * hstep;
    const unsigned ldsw = (unsigned)wid * 1024u;
    const int aoff = lds_byte(wr * 64 + fr, fq * 8), boff = lds_byte(wc * 32 + fr, fq * 8);
#define PG8_SA(b, h) (((b) * 2 + (h)) * HTB)
#define PG8_SB(b, h) ((4 + (b) * 2 + (h)) * HTB)
#define PG8_STAGE(bufoff, gbase, voff) do { _Pragma("unroll") for (int _i = 0; _i < 2; ++_i) \
        __builtin_amdgcn_global_load_lds((const unsigned*)((const char*)(gbase) + (voff)[_i]), (PG8_LAS unsigned*)(lds + (bufoff) + ldsw + _i * 8192), 16, 0, 0); } while (0)
#define PG8_LDA(dst, b, h) do { _Pragma("unroll") for (int m = 0; m < 4; ++m) _Pragma("unroll") for (int k = 0; k < 2; ++k) dst[m][k] = *(const PG8_LAS bf16x8*)(lds + PG8_SA(b, h) + aoff + m * 2048 + k * 1024); } while (0)
#define PG8_LDB(dst, b, h) do { _Pragma("unroll") for (int n = 0; n < 2; ++n) _Pragma("unroll") for (int k = 0; k < 2; ++k) dst[n][k] = *(const PG8_LAS bf16x8*)(lds + PG8_SB(b, h) + boff + n * 2048 + k * 1024); } while (0)
#define PG8_MMA(ai, bj, At, Bt) do { __builtin_amdgcn_s_setprio(1); _Pragma("unroll") for (int m = 0; m < 4; ++m) _Pragma("unroll") for (int n = 0; n < 2; ++n) _Pragma("unroll") for (int k = 0; k < 2; ++k) \
        acc[ai][bj][m][n] = __builtin_amdgcn_mfma_f32_16x16x32_bf16(Bt[n][k], At[m][k], acc[ai][bj][m][n], 0, 0, 0); __builtin_amdgcn_s_setprio(0); } while (0)
#define PG8_WAIT_V(n) asm volatile("s_waitcnt vmcnt(" #n ")" ::: "memory")
#define PG8_WAIT_L(n) asm volatile("s_waitcnt lgkmcnt(" #n ")" ::: "memory")
#define PG8_BAR __builtin_amdgcn_s_barrier()
#define PG8_SCHED __builtin_amdgcn_sched_barrier(0)
    Unit cur, nxt; int ui = 0;
    if (!S.next(0, cur)) return;
    f32x4 acc[2][2][4][2];
#pragma unroll
    for (int a = 0; a < 2; ++a)
#pragma unroll
        for (int b = 0; b < 2; ++b)
#pragma unroll
            for (int m = 0; m < 4; ++m)
#pragma unroll
                for (int n = 0; n < 2; ++n) acc[a][b][m][n] = (f32x4){0.f, 0.f, 0.f, 0.f};
    bf16x8 At[4][2], B0[2][2], B1[2][2];
    const char* cA = (const char*)g.A + (size_t)cur.pm * tstep; const char* cB = (const char*)g.Bt + (size_t)cur.pn * tstep;
    S.a_ready(cur);
    if constexpr (SP2) {
        PG8_STAGE(PG8_SB(0, 0), cB, voffB); PG8_STAGE(PG8_SB(0, 1), cB + hstep, voffB); PG8_STAGE(PG8_SA(0, 0), cA, voffA); PG8_STAGE(PG8_SA(0, 1), cA + hstep, voffA);
        if (wr == 1) PG8_BAR;
        PG8_WAIT_V(2); PG8_BAR;
        PG8_STAGE(PG8_SB(1, 0), cB + kstep, voffB); PG8_STAGE(PG8_SA(1, 0), cA + kstep, voffA); PG8_STAGE(PG8_SB(1, 1), cB + hstep + kstep, voffB);
        PG8_WAIT_V(6); PG8_BAR;
    } else {
        PG8_STAGE(PG8_SB(0, 0), cB, voffB); PG8_STAGE(PG8_SA(0, 0), cA, voffA); PG8_STAGE(PG8_SB(0, 1), cB + hstep, voffB); PG8_STAGE(PG8_SA(0, 1), cA + hstep, voffA);
        if (wr == 1) PG8_BAR;
        PG8_WAIT_V(4); PG8_BAR;
        PG8_STAGE(PG8_SB(1, 0), cB + kstep, voffB); PG8_STAGE(PG8_SA(1, 0), cA + kstep, voffA); PG8_STAGE(PG8_SB(1, 1), cB + hstep + kstep, voffB);
        PG8_WAIT_V(6); PG8_BAR;
    }
    for (;;) {
        const bool has_next = S.next(ui + 1, nxt);
        const char* nA = has_next ? (const char*)g.A + (size_t)nxt.pm * tstep : cA; const char* nB = has_next ? (const char*)g.Bt + (size_t)nxt.pn * tstep : cB;
        for (int t = 0; t < nt; t += 2) {
            const bool last = (t == nt - 2);
            const char* a1 = cA + (size_t)(t + 1) * kstep;
            const char* a2 = last ? nA : cA + (size_t)(t + 2) * kstep; const char* b2 = last ? nB : cB + (size_t)(t + 2) * kstep;
            const char* a3 = a2 + kstep; const char* b3 = b2 + kstep;
            if (last && has_next) S.a_ready(nxt);
            if constexpr (SP2) {
            PG8_LDB(B0, 0, 0); PG8_LDB(B1, 0, 1); PG8_SCHED; PG8_LDA(At, 0, 0); PG8_STAGE(PG8_SA(1, 1), a1 + hstep, voffA);
            PG8_WAIT_V(8); PG8_WAIT_L(0); PG8_BAR; PG8_MMA(0, 0, At, B0); PG8_MMA(0, 1, At, B1); PG8_BAR; PG8_SCHED;
            PG8_LDA(At, 0, 1); PG8_STAGE(PG8_SB(0, 0), b2, voffB); PG8_STAGE(PG8_SB(0, 1), b2 + hstep, voffB); PG8_STAGE(PG8_SA(0, 0), a2, voffA);
            PG8_WAIT_V(8); PG8_WAIT_L(0); PG8_BAR; PG8_MMA(1, 0, At, B0); PG8_MMA(1, 1, At, B1); PG8_BAR; PG8_SCHED;
            PG8_LDB(B0, 1, 0); PG8_LDB(B1, 1, 1); PG8_SCHED; PG8_LDA(At, 1, 0); PG8_STAGE(PG8_SA(0, 1), a2 + hstep, voffA);
            PG8_WAIT_V(8); PG8_WAIT_L(0); PG8_BAR; PG8_MMA(0, 0, At, B0); PG8_MMA(0, 1, At, B1); PG8_BAR; PG8_SCHED;
            PG8_LDA(At, 1, 1); PG8_STAGE(PG8_SB(1, 0), b3, voffB); PG8_STAGE(PG8_SB(1, 1), b3 + hstep, voffB); PG8_STAGE(PG8_SA(1, 0), a3, voffA);
            PG8_WAIT_V(8); PG8_WAIT_L(0); PG8_BAR; PG8_MMA(1, 0, At, B0); PG8_MMA(1, 1, At, B1); PG8_BAR; PG8_SCHED;
            } else {
            PG8_LDB(B0, 0, 0); PG8_SCHED; PG8_LDA(At, 0, 0); PG8_STAGE(PG8_SA(1, 1), a1 + hstep, voffA);
            PG8_WAIT_L(8); PG8_BAR; PG8_WAIT_L(0); PG8_MMA(0, 0, At, B0); PG8_BAR; PG8_SCHED;
            PG8_LDB(B1, 0, 1); PG8_STAGE(PG8_SB(0, 0), b2, voffB);
            PG8_BAR; PG8_WAIT_L(0); PG8_MMA(0, 1, At, B1); PG8_BAR;
            PG8_LDA(At, 0, 1); PG8_STAGE(PG8_SA(0, 0), a2, voffA);
            PG8_BAR; PG8_WAIT_L(0); PG8_MMA(1, 0, At, B0); PG8_BAR; PG8_SCHED;
            PG8_STAGE(PG8_SB(0, 1), b2 + hstep, voffB);
            PG8_WAIT_V(6); PG8_BAR; PG8_MMA(1, 1, At, B1); PG8_BAR;
            PG8_LDB(B0, 1, 0); PG8_SCHED; PG8_LDA(At, 1, 0); PG8_STAGE(PG8_SA(0, 1), a2 + hstep, voffA);
            PG8_WAIT_L(8); PG8_BAR; PG8_WAIT_L(0); PG8_MMA(0, 0, At, B0); PG8_BAR; PG8_SCHED;
            PG8_LDB(B1, 1, 1); PG8_STAGE(PG8_SB(1, 0), b3, voffB);
            PG8_BAR; PG8_WAIT_L(0); PG8_MMA(0, 1, At, B1); PG8_BAR;
            PG8_LDA(At, 1, 1); PG8_STAGE(PG8_SA(1, 0), a3, voffA);
            PG8_BAR; PG8_WAIT_L(0); PG8_MMA(1, 0, At, B0); PG8_BAR; PG8_SCHED;
            PG8_STAGE(PG8_SB(1, 1), b3 + hstep, voffB);
            PG8_WAIT_V(6); PG8_BAR; PG8_MMA(1, 1, At, B1); PG8_BAR;
            }
        }
        if constexpr (ALIGN_EPI) { if (wr == 0) PG8_BAR; }
        if constexpr (!Epi::AFTER_DRAIN) { int fr_l = fr, fq_l = fq; asm volatile("" : "+v"(fr_l), "+v"(fq_l)); E(acc, cur, wr, wc, fr_l, fq_l); S.done(cur); }
        if (!has_next) break;
#pragma unroll
        for (int a = 0; a < 2; ++a)
#pragma unroll
            for (int b = 0; b < 2; ++b)
#pragma unroll
                for (int m = 0; m < 4; ++m)
#pragma unroll
                    for (int n = 0; n < 2; ++n) acc[a][b][m][n] = (f32x4){0.f, 0.f, 0.f, 0.f};
        cur = nxt; cA = nA; cB = nB; ++ui;
        if constexpr (ALIGN_EPI) { if (wr == 1) PG8_BAR; }
    }
    PG8_WAIT_V(0);
    if constexpr (!ALIGN_EPI) { if (wr == 0) PG8_BAR; }
    PG8_BAR;
    if constexpr (Epi::AFTER_DRAIN) { E.fused(acc, cur, wr, wc, fr, fq, lds, wid, lane); S.done(cur); }
#undef PG8_SA
#undef PG8_SB
#undef PG8_STAGE
#undef PG8_LDA
#undef PG8_LDB
#undef PG8_MMA
#undef PG8_WAIT_V
#undef PG8_WAIT_L
#undef PG8_BAR
#undef PG8_SCHED
}
}

#ifndef PG8_SP2
#define PG8_SP2 true
#endif
#ifndef PG8_ALIGN
#define PG8_ALIGN true
#endif
#include <hip/hip_bf16.h>
#include <cmath>
namespace attn_body {
using bf16=__hip_bfloat16;
using bf16x8=__attribute__((ext_vector_type(8)))short;
using s16x4=__attribute__((ext_vector_type(4)))short;
using f32x16=__attribute__((ext_vector_type(16)))float;
using u32x4=__attribute__((ext_vector_type(4)))unsigned;
constexpr int SEQ=2048,D=64,DM=1024,ODM=2048;
constexpr int NW=8,QBLK=32,QB=QBLK*NW,KVBLK=64,NQB=SEQ/QB;
constexpr int ATTN_PITCH=DM, ATTN_UNIT_ROWS=QB;
__device__ __forceinline__ int crow(int r,int hi){return (r&3)+8*(r>>2)+4*hi;}
#define SBAR() __builtin_amdgcn_sched_barrier(0)
__device__ __forceinline__ void cmask(f32x16&p0,f32x16&p1,int jb,int qrel,int hi){
  const float NEG=-INFINITY; int kb=64*jb+4*hi;
  #pragma unroll
  for(int r=0;r<16;++r){int kv=kb+(r&3)+8*(r>>2); if(kv>qrel)p0[r]=NEG; if(kv+32>qrel)p1[r]=NEG;}
}

constexpr int NSLOT=3, SLOTB=8192;
constexpr int LDS_K=0, LDS_V=NSLOT*SLOTB, LDS_WS=2*NSLOT*SLOTB, LDS_OST=LDS_WS+NW*64*4, LDS_BYTES=LDS_OST+NW*4096;
constexpr float C2=0.125f*1.4426950408889634f;
__device__ __forceinline__ void glds16(const void*gsrc,unsigned lds_dst){unsigned keep;
  asm volatile("s_mov_b32 %0, m0\n\ts_mov_b32 m0, %2\n\ts_nop 0\n\tglobal_load_lds_dwordx4 %1, off\n\ts_mov_b32 m0, %0":"=&s"(keep):"v"(gsrc),"s"(lds_dst):"memory");}
__device__ __forceinline__ float max3f(float a,float b,float c){float r;asm("v_max3_f32 %0, %1, %2, %3":"=v"(r):"v"(a),"v"(b),"v"(c));return r;}
__device__ __forceinline__ float max2f(float a,float b){float r;asm("v_max_f32_e32 %0, %1, %2":"=v"(r):"v"(a),"v"(b));return r;}
__device__ __forceinline__ float fadd_s(float a,float b){float r;asm("v_add_f32_e32 %0, %1, %2":"=v"(r):"v"(a),"v"(b));return r;}
__device__ __forceinline__ float fsub_s(float a,float b){float r;asm("v_sub_f32_e32 %0, %1, %2":"=v"(r):"v"(a),"v"(b));return r;}
typedef float f32x2_t __attribute__((ext_vector_type(2))); typedef __bf16 bf16x2_t __attribute__((ext_vector_type(2)));
__device__ __forceinline__ unsigned cvtpk_s(float lo,float hi){f32x2_t v={lo,hi};bf16x2_t b=__builtin_convertvector(v,bf16x2_t);return __builtin_bit_cast(unsigned,b);}
#define WAIT_BAR(N) asm volatile("s_waitcnt vmcnt(" #N ") lgkmcnt(0)\n\ts_barrier":::"memory")

__device__ __forceinline__ void qkt(f32x16&p0,f32x16&p1,const char*Kslot,const bf16x8*qr,const f32x16&negm,int r32,int hi){
  const char*kb=Kslot+hi*1024+r32*16;
  #pragma unroll
  for(int d0=0;d0<4;++d0){
    const bf16x8 b0=*reinterpret_cast<const bf16x8*>(kb+d0*2048);
    const bf16x8 b1=*reinterpret_cast<const bf16x8*>(kb+d0*2048+512);
    if(d0==0){p0=__builtin_amdgcn_mfma_f32_32x32x16_bf16(b0,qr[0],negm,0,0,0);p1=__builtin_amdgcn_mfma_f32_32x32x16_bf16(b1,qr[0],negm,0,0,0);}
    else{p0=__builtin_amdgcn_mfma_f32_32x32x16_bf16(b0,qr[d0],p0,0,0,0);p1=__builtin_amdgcn_mfma_f32_32x32x16_bf16(b1,qr[d0],p1,0,0,0);}}
}
typedef __attribute__((address_space(3))) const char* lds_cptr;
typedef short v4i16_t __attribute__((ext_vector_type(4)));
__device__ __forceinline__ void kload8(bf16x8*kf,lds_cptr kp){
  kf[0]=*(const __attribute__((address_space(3))) bf16x8*)(kp);      kf[1]=*(const __attribute__((address_space(3))) bf16x8*)(kp+512);
  kf[2]=*(const __attribute__((address_space(3))) bf16x8*)(kp+2048); kf[3]=*(const __attribute__((address_space(3))) bf16x8*)(kp+2560);
  kf[4]=*(const __attribute__((address_space(3))) bf16x8*)(kp+4096); kf[5]=*(const __attribute__((address_space(3))) bf16x8*)(kp+4608);
  kf[6]=*(const __attribute__((address_space(3))) bf16x8*)(kp+6144); kf[7]=*(const __attribute__((address_space(3))) bf16x8*)(kp+6656);
}
__device__ __forceinline__ void kload2(bf16x8*kf,lds_cptr kp,int j){ kf[2*j]=*(const __attribute__((address_space(3))) bf16x8*)(kp+j*2048); kf[2*j+1]=*(const __attribute__((address_space(3))) bf16x8*)(kp+j*2048+512); }
__device__ __forceinline__ s16x4 vtr(lds_cptr p){ return __builtin_bit_cast(s16x4,__builtin_amdgcn_ds_read_tr16_b64_v4i16((__attribute__((address_space(3))) v4i16_t*)p)); }
__device__ __forceinline__ float rowmax(const f32x16&p0,const f32x16&p1){
  float a=max3f(p0[0],p0[1],p1[0]),b=max3f(p0[2],p0[3],p1[1]);a=max3f(a,p1[2],p1[3]);
  #pragma unroll
  for(int r=4;r<16;r+=4){a=max3f(a,p0[r],p0[r+1]);b=max3f(b,p0[r+2],p0[r+3]);a=max3f(a,p1[r],p1[r+1]);b=max3f(b,p1[r+2],p1[r+3]);}
  const float m=max2f(a,b);
  auto rr=__builtin_amdgcn_permlane32_swap(__float_as_uint(m),__float_as_uint(m),false,false);
  return max2f(__uint_as_float(rr[0]),__uint_as_float(rr[1]));
}
__device__ __forceinline__ void pv(f32x16*o,int vb,bf16x8 pa0,bf16x8 pa1,bf16x8 pa2,bf16x8 pa3){
  #pragma unroll
  for(int d0=0;d0<2;++d0){s16x4 lo[4],hi[4];
    #pragma unroll
    for(int ks=0;ks<4;++ks){
      asm volatile("ds_read_b64_tr_b16 %0,%1 offset:%c2":"=&v"(lo[ks]):"v"(vb),"i"(d0*4096+ks*1024):"memory");
      asm volatile("ds_read_b64_tr_b16 %0,%1 offset:%c2":"=&v"(hi[ks]):"v"(vb),"i"(d0*4096+ks*1024+512):"memory");}
    asm volatile("s_waitcnt lgkmcnt(0)":::"memory");SBAR();
    #define PK(k) (bf16x8){lo[k][0],lo[k][1],lo[k][2],lo[k][3],hi[k][0],hi[k][1],hi[k][2],hi[k][3]}
    o[d0]=__builtin_amdgcn_mfma_f32_32x32x16_bf16(pa0,PK(0),o[d0],0,0,0);
    o[d0]=__builtin_amdgcn_mfma_f32_32x32x16_bf16(pa1,PK(1),o[d0],0,0,0);
    o[d0]=__builtin_amdgcn_mfma_f32_32x32x16_bf16(pa2,PK(2),o[d0],0,0,0);
    o[d0]=__builtin_amdgcn_mfma_f32_32x32x16_bf16(pa3,PK(3),o[d0],0,0,0);
    #undef PK
  }
}

#ifndef ATTN_STORE16
#define ATTN_STORE16(p,v) (*(u32x4*)(p)=(v))
#endif
template<int THRL> __device__ __forceinline__ void attn_unit(int b,int qc,int kc,int vc,int oc,int qb,const bf16*Q,const bf16*__restrict__ K,const bf16*__restrict__ V,bf16*O,char*shm){
  int tid_l=threadIdx.x; asm volatile("":"+v"(tid_l)); const int tid=tid_l,lane=tid&63,r32=lane&31,hi=lane>>5; const int wid=__builtin_amdgcn_readfirstlane(tid>>6);
  const long rowbase=(long)b*SEQ; const int q0=qb*QB;
  const bf16*Qw=Q+(rowbase+q0+wid*QBLK)*DM+qc;
  const bf16*Kh=K+rowbase*DM+kc,*Vh=V+rowbase*DM+vc;
  const unsigned lds0=(unsigned)(uintptr_t)shm;
  float*wsf=(float*)(shm+LDS_WS)+wid*64;
  const bf16*ksrc=Kh+(long)lane*DM+wid*8;
  const bf16*vsrc=Vh+(long)(16*(wid&3)+(lane>>2))*DM+(wid>>2)*32+(lane&3)*8;
  const unsigned kdst=lds0+LDS_K+wid*1024, vdst=lds0+LDS_V+wid*1024;
  #define DMA_K(t,slot) glds16(ksrc+(long)(t)*KVBLK*DM,(unsigned)__builtin_amdgcn_readfirstlane(kdst+(slot)))
  #define DMA_V(t,slot) glds16(vsrc+(long)(t)*KVBLK*DM,(unsigned)__builtin_amdgcn_readfirstlane(vdst+(slot)))
  const int vb0=(int)(lds0+LDS_V)+((lane>>4)&1)*32+(lane&3)*8+(4*hi+((lane&15)>>2))*64;
  const char*Kbase=shm+LDS_K; bf16x8 kf[8];
  const lds_cptr shm3=(lds_cptr)shm; const lds_cptr kp0=shm3+LDS_K+hi*1024+r32*16; const lds_cptr vp0=shm3+LDS_V+((lane>>4)&1)*32+(lane&3)*8+(4*hi+((lane&15)>>2))*64;
  const int NT=(q0+QB)/KVBLK;
  DMA_K(0,0);DMA_V(0,0);DMA_K(1,SLOTB);
  bf16x8 qr[4];
  #pragma unroll
  for(int d0=0;d0<4;++d0)qr[d0]=*reinterpret_cast<const bf16x8*>(&Qw[(long)r32*DM+d0*16+hi*8]);
  float mhat=0.f,l_reg=0.f;f32x16 o[2];float zf_=0.f;asm volatile("":"+v"(zf_));f32x16 zv_;
  #pragma unroll
  for(int r=0;r<16;++r)zv_[r]=zf_;
  o[0]=zv_;o[1]=zv_;f32x16 negm=zv_;asm volatile("":"+v"(negm));
  const int qrel=wid*QBLK+r32;
  #define CMASK(P0,P1,t) do{int jb_=(t)-(NT-4); if(jb_>=0)cmask(P0,P1,jb_,qrel,hi);}while(0)
  bool resc=false;
  #define START(P0,P1) do{ const float rm=rowmax(P0,P1); resc=false; \
    { const float dl=rm; mhat=fadd_s(mhat,dl); \
      _Pragma("unroll") for(int r=0;r<16;++r){P0[r]=fsub_s(P0[r],dl);P1[r]=fsub_s(P1[r],dl);} \
      _Pragma("unroll") for(int r=0;r<16;++r)negm[r]=-mhat; asm volatile("":"+v"(negm)); } \
    _Pragma("unroll") for(int r=0;r<16;++r)P0[r]=__builtin_amdgcn_exp2f(P0[r]); }while(0)
  #define RESC() do{ if(resc){ asm volatile("s_waitcnt lgkmcnt(0)":::"memory"); \
      _Pragma("unroll") for(int d_=0;d_<2;++d_) _Pragma("unroll") for(int r=0;r<16;++r)o[d_][r]*=wsf[crow(r,hi)]; } }while(0)
  f32x16 pA0,pA1,pB0,pB1;
  int sl_prev=0,sl_cur=0,sl_next=SLOTB;
  #define ROT() do{sl_prev=sl_cur;sl_cur=sl_next;sl_next=(sl_next==(NSLOT-1)*SLOTB)?0:sl_next+SLOTB;}while(0)
  DMA_K(2,2*SLOTB);
  WAIT_BAR(3);
  qkt(pA0,pA1,Kbase,qr,negm,r32,hi);asm volatile("s_nop 15\n\ts_nop 7":"+v"(pA0),"+v"(pA1));CMASK(pA0,pA1,0);
  START(pA0,pA1);
  _Pragma("unroll") for(int r=0;r<16;++r)pA1[r]=__builtin_amdgcn_exp2f(pA1[r]);
  WAIT_BAR(0);
  DMA_K(3,0);DMA_V(1,SLOTB);
  ROT();
  kload8(kf,kp0+sl_cur);
  WAIT_BAR(2);
  s16x4 vlo[8],vhi[8]; u32x4 pw0,pw1,pw2,pw3;
  #define PKW(P,B) cvtpk_s(P[B],P[B+1])
  #define PAF(k) __builtin_bit_cast(bf16x8,pw##k)
  #define VFR(i) (bf16x8){vlo[i][0],vlo[i][1],vlo[i][2],vlo[i][3],vhi[i][0],vhi[i][1],vhi[i][2],vhi[i][3]}
  #define PIN(x) asm volatile("":"+v"(x))
  #define MX3(a,b,c) __builtin_fmaxf(__builtin_fmaxf((a),(b)),(c))
  #define GAPA(MF,A0,A1,A2,A3,W0,W1,PW) do{ MF; sacc+=A0; sacc+=A1; sacc+=A2; sacc+=A3; PIN(sacc); W0; W1; PIN(PW); SBAR(); }while(0)
  #define EX(v) __builtin_amdgcn_exp2f(v)
  #define GAPB(MF,X,B) do{ MF; X[B]=EX(X[B]); X[B+1]=EX(X[B+1]); X[B+2]=EX(X[B+2]); X[B+3]=EX(X[B+3]); PIN(X); SBAR(); }while(0)
  #define VRD(i) do{ vlo[i]=vtr(vp_+(((i)>>2)*4096+((i)&3)*1024)); vhi[i]=vtr(vp_+(((i)>>2)*4096+((i)&3)*1024+512)); }while(0)
  #define KRD(G,j) do{ if(G){ kload2(kf,kp0+sl_next,j); SBAR(); } }while(0)
  #define STEP(C0,C1,P0,P1,t,GK,GV,GL) do{ SBAR(); \
    const lds_cptr vp_=vp0+sl_prev; \
    VRD(0); SBAR(); float sacc=(P0[0]+P0[1]); \
    GAPA(C0=__builtin_amdgcn_mfma_f32_32x32x16_bf16(kf[0],qr[0],negm,0,0,0), P0[2],P0[3],P0[4],P0[5],     pw0[0]=PKW(P0,0), pw0[1]=PKW(P0,2), pw0); \
    VRD(4); SBAR(); GAPA(C1=__builtin_amdgcn_mfma_f32_32x32x16_bf16(kf[1],qr[0],negm,0,0,0), P0[6],P0[7],P0[8],P0[9],     pw0[2]=PKW(P0,4), pw0[3]=PKW(P0,6), pw0); \
    VRD(1); SBAR(); GAPA(C0=__builtin_amdgcn_mfma_f32_32x32x16_bf16(kf[2],qr[1],C0,0,0,0),   P0[10],P0[11],P0[12],P0[13], pw1[0]=PKW(P0,8), pw1[1]=PKW(P0,10), pw1); \
    VRD(5); SBAR(); GAPA(C1=__builtin_amdgcn_mfma_f32_32x32x16_bf16(kf[3],qr[1],C1,0,0,0),   P0[14],P0[15],P1[0],P1[1],   pw1[2]=PKW(P0,12),pw1[3]=PKW(P0,14), pw1); \
    VRD(2); SBAR(); GAPA(C0=__builtin_amdgcn_mfma_f32_32x32x16_bf16(kf[4],qr[2],C0,0,0,0),   P1[2],P1[3],P1[4],P1[5],     pw2[0]=PKW(P1,0), pw2[1]=PKW(P1,2), pw2); \
    VRD(6); SBAR(); GAPA(C1=__builtin_amdgcn_mfma_f32_32x32x16_bf16(kf[5],qr[2],C1,0,0,0),   P1[6],P1[7],P1[8],P1[9],     pw2[2]=PKW(P1,4), pw2[3]=PKW(P1,6), pw2); \
    VRD(3); SBAR(); GAPA(C0=__builtin_amdgcn_mfma_f32_32x32x16_bf16(kf[6],qr[3],C0,0,0,0),   P1[10],P1[11],P1[12],P1[13], pw3[0]=PKW(P1,8), pw3[1]=PKW(P1,10), pw3); \
    VRD(7); SBAR(); GAPA(C1=__builtin_amdgcn_mfma_f32_32x32x16_bf16(kf[7],qr[3],C1,0,0,0),   P1[14],P1[15],0.f,0.f,       pw3[2]=PKW(P1,12),pw3[3]=PKW(P1,14), pw3); \
    l_reg+=sacc; \
    if(GK){DMA_K((t)+3,sl_cur);} if(GV){DMA_V((t)+1,sl_next);} \
    CMASK(C0,C1,t); \
    { float a=MX3(C0[0],C0[1],C1[0]),b=MX3(C0[2],C0[3],C1[1]); a=MX3(a,C1[2],C1[3]); \
      _Pragma("unroll") for(int r=4;r<16;r+=4){a=MX3(a,C0[r],C0[r+1]);b=MX3(b,C0[r+2],C0[r+3]);a=MX3(a,C1[r],C1[r+1]);b=MX3(b,C1[r+2],C1[r+3]);} \
      float rm=__builtin_fmaxf(a,b); { auto rr=__builtin_amdgcn_permlane32_swap(__float_as_uint(rm),__float_as_uint(rm),false,false); rm=__builtin_fmaxf(__uint_as_float(rr[0]),__uint_as_float(rr[1])); } \
      resc=false; \
      if(__builtin_expect(__any(rm>(float)THRL),0)){ const float dl=__builtin_fmaxf(rm,0.f); mhat+=dl; \
        _Pragma("unroll") for(int r=0;r<16;++r){C0[r]-=dl;C1[r]-=dl;} \
        _Pragma("unroll") for(int r=0;r<16;++r)negm[r]=-mhat; asm volatile("":"+v"(negm)); \
        const float f=__builtin_amdgcn_exp2f(-dl); l_reg*=f; if(hi==0)wsf[r32]=f; resc=true; } } \
    SBAR(); \
    GAPB(o[0]=__builtin_amdgcn_mfma_f32_32x32x16_bf16(PAF(0),VFR(0),o[0],0,0,0), C0,0); \
    GAPB(o[1]=__builtin_amdgcn_mfma_f32_32x32x16_bf16(PAF(0),VFR(4),o[1],0,0,0), C0,4); \
    KRD(GL,0); GAPB(o[0]=__builtin_amdgcn_mfma_f32_32x32x16_bf16(PAF(1),VFR(1),o[0],0,0,0), C0,8); \
    KRD(GL,1); GAPB(o[1]=__builtin_amdgcn_mfma_f32_32x32x16_bf16(PAF(1),VFR(5),o[1],0,0,0), C0,12); \
    KRD(GL,2); GAPB(o[0]=__builtin_amdgcn_mfma_f32_32x32x16_bf16(PAF(2),VFR(2),o[0],0,0,0), C1,0); \
    KRD(GL,3); GAPB(o[1]=__builtin_amdgcn_mfma_f32_32x32x16_bf16(PAF(2),VFR(6),o[1],0,0,0), C1,4); \
    GAPB(o[0]=__builtin_amdgcn_mfma_f32_32x32x16_bf16(PAF(3),VFR(3),o[0],0,0,0), C1,8); \
    GAPB(o[1]=__builtin_amdgcn_mfma_f32_32x32x16_bf16(PAF(3),VFR(7),o[1],0,0,0), C1,12); \
    }while(0)
  int t=1;
  #undef CMASK
  #define CMASK(P0,P1,t) do{}while(0)
  for(;t+5<NT;t+=2){
    STEP(pB0,pB1,pA0,pA1,t,true,true,true);     WAIT_BAR(2); RESC(); ROT();
    STEP(pA0,pA1,pB0,pB1,t+1,true,true,true);   WAIT_BAR(2); RESC(); ROT();
  }
  #undef CMASK
  #define CMASK(P0,P1,t) do{int jb_=(t)-(NT-4); if(jb_>=0)cmask(P0,P1,jb_,qrel,hi);}while(0)
  #define ENDW(tt) do{ if((tt)+3<NT){WAIT_BAR(2);} else if((tt)+2<NT){WAIT_BAR(1);} else {WAIT_BAR(0);} }while(0)
  for(;t+1<NT;t+=2){
    STEP(pB0,pB1,pA0,pA1,t,(t+3<NT),(t+1<NT),(t+1<NT));       ENDW(t);   RESC(); ROT();
    STEP(pA0,pA1,pB0,pB1,t+1,(t+4<NT),(t+2<NT),(t+2<NT));     ENDW(t+1); RESC(); ROT();
  }
  STEP(pB0,pB1,pA0,pA1,NT-1,false,false,false); RESC();
  { float sacc=pB0[0]+pB0[1]; _Pragma("unroll") for(int r=2;r<16;++r)sacc+=pB0[r]; _Pragma("unroll") for(int r=0;r<16;++r)sacc+=pB1[r]; l_reg+=sacc;
    pw0=(u32x4){PKW(pB0,0),PKW(pB0,2),PKW(pB0,4),PKW(pB0,6)};pw1=(u32x4){PKW(pB0,8),PKW(pB0,10),PKW(pB0,12),PKW(pB0,14)};pw2=(u32x4){PKW(pB1,0),PKW(pB1,2),PKW(pB1,4),PKW(pB1,6)};pw3=(u32x4){PKW(pB1,8),PKW(pB1,10),PKW(pB1,12),PKW(pB1,14)};
    SBAR(); pv(o,vb0+sl_cur,PAF(0),PAF(1),PAF(2),PAF(3)); }
  #undef PKW
  #undef PAF
  #undef VFR
  #undef PIN
  #undef MX3
  #undef GAPA
  #undef GAPB
  #undef EX
  #undef VRD
  #undef KRD
  #undef STEP
  #undef ENDW
  {auto rr=__builtin_amdgcn_permlane32_swap(__float_as_uint(l_reg),__float_as_uint(l_reg),false,false);l_reg=__uint_as_float(rr[0])+__uint_as_float(rr[1]);}
  if(hi==0)wsf[32+r32]=l_reg;asm volatile("s_waitcnt lgkmcnt(0)":::"memory");
  float rli[16];
  #pragma unroll
  for(int r=0;r<16;++r)rli[r]=__builtin_amdgcn_rcpf(wsf[32+crow(r,hi)]);
  bf16*Ow=O+(rowbase+q0+wid*QBLK)*ODM+oc;
  { bf16*stg=(bf16*)(shm+LDS_OST)+wid*2048;
    #pragma unroll
    for(int r=0;r<16;++r){const int orow=crow(r,hi);
      #pragma unroll
      for(int d0=0;d0<2;++d0)stg[orow*64+d0*32+r32]=__float2bfloat16(o[d0][r]*rli[r]);}
    asm volatile("s_waitcnt lgkmcnt(0)":::"memory");
    #pragma unroll
    for(int i=0;i<4;++i){const int row=i*8+(lane>>3),ch=lane&7; const u32x4 v=*(const u32x4*)(stg+row*64+ch*8); ATTN_STORE16(Ow+(long)row*ODM+ch*8,v);} }
  asm volatile("s_waitcnt lgkmcnt(0)\n\ts_barrier":::"memory");
  #undef DMA_K
  #undef DMA_V
  #undef CMASK
  #undef START
  #undef RESC
  #undef ROT
}
constexpr int ATTN_LDS_BYTES=LDS_BYTES;
#undef SBAR
#undef WAIT_BAR
}
#define GAS __attribute__((address_space(1)))
#define LAS __attribute__((address_space(3)))
typedef unsigned short bf16;
typedef unsigned v4u __attribute__((ext_vector_type(4)));
typedef float f32x4 __attribute__((ext_vector_type(4)));
typedef short bf16x8 __attribute__((ext_vector_type(8)));
typedef GAS unsigned gu32;
typedef GAS unsigned long long gu64;
#define RLX_AGENT __ATOMIC_RELAXED, __HIP_MEMORY_SCOPE_AGENT
#define LDS_WAIT() asm volatile("s_waitcnt lgkmcnt(0)" ::: "memory")
#define VM_WAIT() asm volatile("s_waitcnt vmcnt(0)" ::: "memory")
__device__ __forceinline__ unsigned long long rt() { return __builtin_amdgcn_s_memrealtime(); }
__device__ __forceinline__ unsigned f2bf(float f) { unsigned u = __builtin_bit_cast(unsigned, f); return (u + 0x7fffu + ((u >> 16) & 1u)) >> 16; }
__device__ __forceinline__ unsigned pk2(float lo, float hi) { return f2bf(lo) | (f2bf(hi) << 16); }

#define XB_TMO      128
#define XB_XCNT(j)  (256  + 64 * (j))
#define XB_XSUB(j)  (1280 + 64 * (j))
#define XB_XGEN(j)  (2304 + 64 * (j))
#define XB_TOP      3328
#define XB_TOPGEN   3392
#define XCD_BAR_WORDS 3456
#define XB_SPIN_CAP (1u << 18)

__device__ __forceinline__ unsigned xb_ld(unsigned* p)              { return __hip_atomic_load(p, __ATOMIC_RELAXED, __HIP_MEMORY_SCOPE_AGENT); }
__device__ __forceinline__ unsigned xb_add(unsigned* p, unsigned v) { return __hip_atomic_fetch_add(p, v, __ATOMIC_RELAXED, __HIP_MEMORY_SCOPE_AGENT); }
__device__ __forceinline__ unsigned xb_xcc_id() { return (unsigned)__builtin_amdgcn_s_getreg((3 << 11) | 20) & 0xFu; }
#define XB_SPIN(cond, bar) do { unsigned _sp = 0; while (cond) { __builtin_amdgcn_s_sleep(1); \
    if ((++_sp & 255u) == 0u) { if (xb_ld(&(bar)[XB_TMO])) break; if (_sp > XB_SPIN_CAP) { atomicAdd(&(bar)[XB_TMO], 1u); break; } } } } while (0)

struct XcdBarrier {
    unsigned* bar; unsigned x;
    volatile LAS unsigned* st;
};

__device__ __forceinline__ XcdBarrier xcd_barrier_post(unsigned* bar, volatile LAS unsigned* st) {
    XcdBarrier b; b.bar = bar; b.x = xb_xcc_id(); b.st = st;
    if (threadIdx.x == 0) (void)xb_add(&bar[XB_XCNT(b.x)], 1u);
    return b;
}
__device__ __forceinline__ void xcd_barrier_complete(unsigned* bar, unsigned x, unsigned& nloc, unsigned& nx) {
    const unsigned G = gridDim.x * gridDim.y * gridDim.z;
    unsigned sum, cnt, mine, sp = 0u;
    for (;;) {
        sum = 0u; cnt = 0u; mine = 0u;
#pragma unroll
        for (unsigned j = 0; j < 16; ++j) { const unsigned c = xb_ld(&bar[XB_XCNT(j)]); sum += c; cnt += (c > 0u) ? 1u : 0u; mine = (j == x) ? c : mine; }
        if (sum == G) break;
        __builtin_amdgcn_s_sleep(1);
        if ((++sp & 255u) == 0u) { if (xb_ld(&bar[XB_TMO])) break; if (sp > XB_SPIN_CAP) { atomicAdd(&bar[XB_TMO], 1u); break; } }
    }
    nloc = mine > 0u ? mine : 1u; nx = cnt > 0u ? cnt : 1u;
}

__device__ __forceinline__ void xcd_barrier(const XcdBarrier& b) {
    asm volatile("s_waitcnt vmcnt(0)" ::: "memory");
    __syncthreads();
    if (threadIdx.x == 0) {
        unsigned* bar = b.bar;
        __builtin_amdgcn_s_waitcnt(0);
        unsigned nloc = b.st[0], nx = b.st[1];
        if (nloc == 0u) { xcd_barrier_complete(bar, b.x, nloc, nx); b.st[0] = nloc; b.st[1] = nx; }
        const unsigned old = xb_add(&bar[XB_XSUB(b.x)], 1u);
        const unsigned gen = old / nloc;
        if (old + 1u == (gen + 1u) * nloc) {
            __builtin_amdgcn_fence(__ATOMIC_RELEASE, "agent");
            asm volatile("s_waitcnt vmcnt(0)" ::: "memory");
            const unsigned og = xb_add(&bar[XB_TOP], 1u);
            const unsigned tg = og / nx;
            if (og + 1u == (tg + 1u) * nx) xb_add(&bar[XB_TOPGEN], 1u);
            else XB_SPIN(xb_ld(&bar[XB_TOPGEN]) == tg, bar);
            __builtin_amdgcn_fence(__ATOMIC_ACQUIRE, "agent");
            xb_add(&bar[XB_XGEN(b.x)], 1u);
            asm volatile("s_waitcnt vmcnt(0)" ::: "memory");
        } else {
            XB_SPIN(xb_ld(&bar[XB_XGEN(b.x)]) == gen, bar);
            __builtin_amdgcn_fence(__ATOMIC_ACQUIRE, "agent");
            asm volatile("s_waitcnt vmcnt(0)" ::: "memory");
        }
    }
    __syncthreads();
}

constexpr int RING_OFF = 0, RING_BYTES = 131072;
constexpr int LDSCTL_OFF = RING_BYTES, MISC_OFF = LDSCTL_OFF + 320;
constexpr int LDS_BYTES = 147456;

__device__ __forceinline__ float wave_sum(float v) {
#pragma unroll
    for (int o = 1; o < 64; o <<= 1) v += __shfl_xor(v, o);
    return v;
}
__device__ __forceinline__ float wave_max(float v) {
#pragma unroll
    for (int o = 1; o < 64; o <<= 1) v = fmaxf(v, __shfl_xor(v, o));
    return v;
}
__device__ __forceinline__ float bflo(unsigned w) { return __uint_as_float(w << 16); }
__device__ __forceinline__ float bfhi(unsigned w) { return __uint_as_float(w & 0xffff0000u); }
__device__ __forceinline__ float sigm_(float x) { return __builtin_amdgcn_rcpf(1.f + __expf(-x)); }

__device__ __forceinline__ void p0_transpose_item(const float* W, int K, int N, const float* gk, bf16* WT, int k0, int n0, int orow0, LAS float* scr, int lane) {
    const int kk = lane >> 3, n4 = 4 * (lane & 7);
    f32x4 v[8];
#pragma unroll
    for (int i = 0; i < 8; ++i) v[i] = *(const f32x4*)(W + (size_t)(k0 + kk + 8 * i) * N + n0 + n4);
#pragma unroll
    for (int i = 0; i < 8; ++i) { const float g = gk ? gk[k0 + kk + 8 * i] : 1.f; LAS float* d = scr + (kk + 8 * i) * 33 + n4; d[0] = v[i][0] * g; d[1] = v[i][1] * g; d[2] = v[i][2] * g; d[3] = v[i][3] * g; }
    LDS_WAIT(); asm volatile("" ::: "memory");
    const int c = lane & 7;
#pragma unroll
    for (int j = 0; j < 4; ++j) { const int n = (lane >> 3) + 8 * j; const LAS float* s = scr + (8 * c) * 33 + n;
        v4u o; o.x = pk2(s[0 * 33], s[1 * 33]); o.y = pk2(s[2 * 33], s[3 * 33]); o.z = pk2(s[4 * 33], s[5 * 33]); o.w = pk2(s[6 * 33], s[7 * 33]);
        *(GAS v4u*)(WT + (size_t)(orow0 + n) * K + k0 + 8 * c) = o; }
    LDS_WAIT(); asm volatile("" ::: "memory");
}
__device__ __forceinline__ void sincos_red(float angf, float& c, float& s) {
    const double a = (double)angf, TWO_PI = 6.283185307179586476925;
    const double n = __builtin_rint(a * (1.0 / TWO_PI)); const double r = __builtin_fma(-n, TWO_PI, a), r2 = r * r;
    double sn = 1.0, cs = 1.0;
#pragma unroll
    for (int k = 15; k >= 1; --k) { sn = 1.0 - sn * r2 * (1.0 / (double)((2 * k) * (2 * k + 1))); cs = 1.0 - cs * r2 * (1.0 / (double)((2 * k - 1) * (2 * k))); }
    c = (float)cs; s = (float)(sn * r);
}

template <int NT> __device__ __forceinline__ void block_ln(float (&v)[NT][2], LAS float* red, int tid, int wave, int lane) {
    LAS float* red2 = red + 8 * NT;
#pragma unroll
    for (int t = 0; t < NT; ++t) { const float s = wave_sum(v[t][0] + v[t][1]); if (lane == 0) red[wave * NT + t] = s; }
    __syncthreads();
    if (tid < NT) { float s = 0.f;
#pragma unroll
        for (int w = 0; w < 8; ++w) s += red[w * NT + tid];
        red2[tid] = s * (1.f / 1024.f); }
    __syncthreads();
#pragma unroll
    for (int t = 0; t < NT; ++t) { const float mu = red2[t]; v[t][0] -= mu; v[t][1] -= mu; }
#pragma unroll
    for (int t = 0; t < NT; ++t) { const float s = wave_sum(v[t][0] * v[t][0] + v[t][1] * v[t][1]); if (lane == 0) red[wave * NT + t] = s; }
    __syncthreads();
    if (tid < NT) { float s = 0.f;
#pragma unroll
        for (int w = 0; w < 8; ++w) s += red[w * NT + tid];
        red2[tid] = rsqrtf(s * (1.f / 1024.f) + EPSN); }
    __syncthreads();
#pragma unroll
    for (int t = 0; t < NT; ++t) { const float rs = red2[t]; v[t][0] *= rs; v[t][1] *= rs; }
    __syncthreads();
}

__device__ __forceinline__ void conv_tile(int rowb, int t0, const bf16* Gb, const float* w_dw, const float* b_dw, const float* g_cln, const float* b_cln, bf16* A2, LAS float* red, int tid, int wave, int lane) {
    const int c2 = 2 * tid;
    float w[31][2];
#pragma unroll
    for (int j = 0; j < 31; ++j) { const float2 wv = *(const float2*)(w_dw + j * 1024 + c2); w[j][0] = wv.x; w[j][1] = wv.y; }
    float o[16][2];
#pragma unroll
    for (int t = 0; t < 16; ++t) { o[t][0] = 0.f; o[t][1] = 0.f; }
    const bf16* gp = Gb + (size_t)rowb * 1024 + c2;
#pragma unroll
    for (int ii = 0; ii < 46; ++ii) {
        const int tin = t0 - 30 + ii; unsigned gv = *(const unsigned*)(gp + (size_t)(tin < 0 ? 0 : tin) * 1024);
        if (tin < 0) gv = 0u;
        const float x0 = bflo(gv), x1 = bfhi(gv);
#pragma unroll
        for (int tt = (ii > 30 ? ii - 30 : 0); tt <= (ii < 15 ? ii : 15); ++tt) { o[tt][0] += w[ii - tt][0] * x0; o[tt][1] += w[ii - tt][1] * x1; }
        if (ii == 22) asm volatile("" ::: "memory");
    }
    { const float2 bv = *(const float2*)(b_dw + c2);
#pragma unroll
      for (int t = 0; t < 16; ++t) { o[t][0] += bv.x; o[t][1] += bv.y; } }
    block_ln<16>(o, red, tid, wave, lane);
    const float2 gv = *(const float2*)(g_cln + c2), bb = *(const float2*)(b_cln + c2);
#pragma unroll
    for (int t = 0; t < 16; ++t) { const float y0 = o[t][0] * gv.x + bb.x, y1 = o[t][1] * gv.y + bb.y;
        *(unsigned*)(A2 + (size_t)(rowb + t0 + t) * 1024 + c2) = pk2(y0 * sigm_(y0), y1 * sigm_(y1)); }
}
__device__ __forceinline__ void conv_sample(const float* state_conv, const float* zs, const float* w_dw, const float* b_dw, const float* g_cln, const float* b_cln, bf16* A2, float* ncs, LAS float* red, int tid, int wave, int lane) {
    const int c2 = 2 * tid;
    float o[8][2];
    const float2 bv = *(const float2*)(b_dw + c2);
#pragma unroll
    for (int b = 0; b < 8; ++b) { o[b][0] = bv.x; o[b][1] = bv.y; }
#pragma unroll 2
    for (int j = 0; j < 30; ++j) { const float2 wv = *(const float2*)(w_dw + j * 1024 + c2);
#pragma unroll
        for (int b = 0; b < 8; ++b) { const float2 hv = *(const float2*)(state_conv + ((size_t)b * 30 + j) * 1024 + c2); o[b][0] += wv.x * hv.x; o[b][1] += wv.y * hv.y;
            if (j >= 1) *(float2*)(ncs + ((size_t)b * 30 + j - 1) * 1024 + c2) = hv; } }
    { const float2 wv = *(const float2*)(w_dw + 30 * 1024 + c2);
#pragma unroll
      for (int b = 0; b < 8; ++b) { const float2 gv = *(const float2*)(zs + (size_t)b * 4096 + 3072 + c2); o[b][0] += wv.x * gv.x; o[b][1] += wv.y * gv.y;
          *(float2*)(ncs + ((size_t)b * 30 + 29) * 1024 + c2) = gv; } }
    block_ln<8>(o, red, tid, wave, lane);
    const float2 gv = *(const float2*)(g_cln + c2), bb = *(const float2*)(b_cln + c2);
#pragma unroll
    for (int b = 0; b < 8; ++b) { const float y0 = o[b][0] * gv.x + bb.x, y1 = o[b][1] * gv.y + bb.y;
        *(unsigned*)(A2 + (size_t)(MPR + b) * 1024 + c2) = pk2(y0 * sigm_(y0), y1 * sigm_(y1)); }
}

__device__ __forceinline__ void decode_unit(int unit, int b, int j0, const float* zs, const float* ck, const float* cv, const int* page_table, float* PART, int wave, int lane) {
    const int h = wave, half = lane >> 5, d4 = lane & 31;
    f32x4 q = *(const f32x4*)(zs + (size_t)b * 4096 + h * 128 + 4 * d4); q = q * C2Q;
    float m0 = -INFINITY, m1 = -INFINITY, l0 = 0.f, l1 = 0.f; f32x4 a0 = {0.f, 0.f, 0.f, 0.f}, a1 = a0;
    for (int jj = 0; jj < 4; ++jj) {
        const int pp = page_table[b * 128 + j0 + jj];
        const float* kp = ck + (size_t)pp * (128 * 1024) + (size_t)half * 1024 + h * 128 + 4 * d4;
        const float* vp = cv + (size_t)pp * (128 * 1024) + (size_t)half * 1024 + h * 128 + 4 * d4;
        for (int t0 = 0; t0 < 128; t0 += 16) {
            f32x4 kk[8], vv[8];
#pragma unroll
            for (int i = 0; i < 8; ++i) { kk[i] = __builtin_nontemporal_load((const f32x4*)(kp + (size_t)(t0 + 2 * i) * 1024)); vv[i] = __builtin_nontemporal_load((const f32x4*)(vp + (size_t)(t0 + 2 * i) * 1024)); }
            float s0[8], s1[8]; float bm0 = -INFINITY, bm1 = -INFINITY;
#pragma unroll
            for (int i = 0; i < 8; ++i) { float s = (kk[i][0] * q[0] + kk[i][1] * q[1]) + (kk[i][2] * q[2] + kk[i][3] * q[3]);
                s += __shfl_xor(s, 1); s += __shfl_xor(s, 2); s += __shfl_xor(s, 4); s += __shfl_xor(s, 8);
                const float so = __shfl_xor(s, 16); s0[i] = (d4 < 16) ? s : so; s1[i] = (d4 < 16) ? so : s; bm0 = fmaxf(bm0, s0[i]); bm1 = fmaxf(bm1, s1[i]); }
            const float mn0 = fmaxf(m0, bm0), mn1 = fmaxf(m1, bm1); const float f0 = __builtin_amdgcn_exp2f(m0 - mn0), f1 = __builtin_amdgcn_exp2f(m1 - mn1);
            m0 = mn0; m1 = mn1; l0 *= f0; l1 *= f1; a0 = a0 * f0; a1 = a1 * f1;
#pragma unroll
            for (int i = 0; i < 8; ++i) { const float p0 = __builtin_amdgcn_exp2f(s0[i] - m0), p1 = __builtin_amdgcn_exp2f(s1[i] - m1); l0 += p0; l1 += p1; a0 = a0 + vv[i] * p0; a1 = a1 + vv[i] * p1; }
        }
    }
    { const float mo0 = __shfl_xor(m0, 32), mo1 = __shfl_xor(m1, 32); const float M0 = fmaxf(m0, mo0), M1 = fmaxf(m1, mo1);
      const float fs0 = __builtin_amdgcn_exp2f(m0 - M0), fo0 = __builtin_amdgcn_exp2f(mo0 - M0), fs1 = __builtin_amdgcn_exp2f(m1 - M1), fo1 = __builtin_amdgcn_exp2f(mo1 - M1);
      l0 = l0 * fs0 + __shfl_xor(l0, 32) * fo0; l1 = l1 * fs1 + __shfl_xor(l1, 32) * fo1;
#pragma unroll
      for (int e = 0; e < 4; ++e) { a0[e] = a0[e] * fs0 + __shfl_xor(a0[e], 32) * fo0; a1[e] = a1[e] * fs1 + __shfl_xor(a1[e], 32) * fo1; }
      m0 = M0; m1 = M1; }
    if (half == 0) { float* p0 = PART + (size_t)((unit * 8 + h) * 2) * 132; float* p1 = p0 + 132;
        *(f32x4*)(p0 + 4 + 4 * d4) = a0; *(f32x4*)(p1 + 4 + 4 * d4) = a1;
        if (d4 == 0) { p0[0] = m0; p0[1] = l0; p1[0] = m1; p1[1] = l1; } }
}

__device__ __forceinline__ float lam_value(const float* lq1, const float* lk1, const float* lq2, const float* lk2, int lane) {
    const float s1 = wave_sum(lq1[lane] * lk1[lane]), s2 = wave_sum(lq2[lane] * lk2[lane]);
    return __expf(s1) - __expf(s2) + 0.2f;
}
__device__ __forceinline__ void combine_row(int r, float lam, const bf16* OM, const bf16* GA, const float* g_subln, bf16* A3, int lane) {
    const int h = lane >> 3, e0 = (lane & 7) * 16;
    const v4u* p0 = (const v4u*)(OM + (size_t)r * 2048 + (h * 2) * 128 + e0); const v4u* p1 = (const v4u*)(OM + (size_t)r * 2048 + (h * 2 + 1) * 128 + e0);
    const v4u* pg = (const v4u*)(GA + (size_t)r * 1024 + h * 128 + e0);
    float o[16]; float ss = 0.f;
#pragma unroll
    for (int j = 0; j < 2; ++j) { const v4u a = p0[j], b = p1[j];
        o[8 * j + 0] = bflo(a.x) - lam * bflo(b.x); o[8 * j + 1] = bfhi(a.x) - lam * bfhi(b.x); o[8 * j + 2] = bflo(a.y) - lam * bflo(b.y); o[8 * j + 3] = bfhi(a.y) - lam * bfhi(b.y);
        o[8 * j + 4] = bflo(a.z) - lam * bflo(b.z); o[8 * j + 5] = bfhi(a.z) - lam * bfhi(b.z); o[8 * j + 6] = bflo(a.w) - lam * bflo(b.w); o[8 * j + 7] = bfhi(a.w) - lam * bfhi(b.w); }
#pragma unroll
    for (int e = 0; e < 16; ++e) ss += o[e] * o[e];
    ss += __shfl_xor(ss, 1); ss += __shfl_xor(ss, 2); ss += __shfl_xor(ss, 4);
    const float rms = rsqrtf(ss * (1.f / 128.f) + EPSN) * 0.8f;
    v4u outv[2];
#pragma unroll
    for (int j = 0; j < 2; ++j) { const v4u g = pg[j]; const f32x4 s0 = *(const f32x4*)(g_subln + e0 + 8 * j), s1 = *(const f32x4*)(g_subln + e0 + 8 * j + 4);
        outv[j].x = pk2(o[8 * j + 0] * rms * s0[0] * bflo(g.x), o[8 * j + 1] * rms * s0[1] * bfhi(g.x)); outv[j].y = pk2(o[8 * j + 2] * rms * s0[2] * bflo(g.y), o[8 * j + 3] * rms * s0[3] * bfhi(g.y));
        outv[j].z = pk2(o[8 * j + 4] * rms * s1[0] * bflo(g.z), o[8 * j + 5] * rms * s1[1] * bfhi(g.z)); outv[j].w = pk2(o[8 * j + 6] * rms * s1[2] * bflo(g.w), o[8 * j + 7] * rms * s1[3] * bfhi(g.w)); }
    v4u* po = (v4u*)(A3 + (size_t)r * 2048 + h * 128 + e0); po[0] = outv[0]; po[1] = outv[1];
}
__device__ __forceinline__ void combine_sample(int b, int h, float lam, const float* PART, const float* zs, const bf16* GA, const float* g_subln, bf16* A3, int lane) {
    float om[2][2];
#pragma unroll
    for (int m = 0; m < 2; ++m) {
        const float* prec = PART + (size_t)(((b * 32 + (lane & 31)) * 8 + h) * 2 + m) * 132;
        float pm = -INFINITY, pl = 0.f; if (lane < 32) { pm = prec[0]; pl = prec[1]; }
        float sd = 0.f;
        if (lane < 16) { const f32x4 qv = *(const f32x4*)(zs + (size_t)b * 4096 + h * 128 + m * 64 + 4 * lane), kv = *(const f32x4*)(zs + (size_t)b * 4096 + 1024 + h * 128 + m * 64 + 4 * lane);
            sd = (qv[0] * kv[0] + qv[1] * kv[1]) + (qv[2] * kv[2] + qv[3] * kv[3]); }
        const float sself = wave_sum(sd) * C2Q;
        const float M = fmaxf(wave_max(pm), sself);
        const float wi = __builtin_amdgcn_exp2f(pm - M), wself = __builtin_amdgcn_exp2f(sself - M);
        const float L = wave_sum(wi * pl) + wself;
        const float2 vs = *(const float2*)(zs + (size_t)b * 4096 + 2048 + h * 128 + 2 * lane);
        float a0 = wself * vs.x, a1 = wself * vs.y;
        float2 av[32];
#pragma unroll
        for (int i = 0; i < 32; ++i) av[i] = *(const float2*)(PART + (size_t)(((b * 32 + i) * 8 + h) * 2 + m) * 132 + 4 + 2 * lane);
#pragma unroll
        for (int i = 0; i < 32; ++i) { const float w = __shfl(wi, i); a0 += w * av[i].x; a1 += w * av[i].y; }
        const float rl = 1.f / L; om[m][0] = a0 * rl; om[m][1] = a1 * rl;
    }
    const float o0 = om[0][0] - lam * om[1][0], o1 = om[0][1] - lam * om[1][1];
    const float rms = rsqrtf(wave_sum(o0 * o0 + o1 * o1) * (1.f / 128.f) + EPSN) * 0.8f;
    const unsigned g = *(const unsigned*)(GA + (size_t)(MPR + b) * 1024 + h * 128 + 2 * lane); const float2 sv = *(const float2*)(g_subln + 2 * lane);
    *(unsigned*)(A3 + (size_t)(MPR + b) * 2048 + h * 128 + 2 * lane) = pk2(o0 * rms * sv.x * bflo(g), o1 * rms * sv.y * bfhi(g));
}

__device__ __forceinline__ float skinny_unit(const bf16* A, const bf16* Bt, int n0, LAS float* red, int tid, int wave, int lane) {
    const int r = lane & 15, kq = lane >> 4, kb = wave * 256 + 8 * kq;
    f32x4 c0 = {0.f, 0.f, 0.f, 0.f}, c1 = c0;
    const bf16x8 zero = {0, 0, 0, 0, 0, 0, 0, 0};
    bf16x8 af[8], bf0[8], bf1[8];
#pragma unroll
    for (int s = 0; s < 8; ++s) { const int k = kb + 32 * s;
        af[s] = (r < 8) ? *(const bf16x8*)(A + (size_t)r * 2048 + k) : zero;
        bf0[s] = *(const bf16x8*)(Bt + (size_t)(n0 + r) * 2048 + k); bf1[s] = *(const bf16x8*)(Bt + (size_t)(n0 + 16 + r) * 2048 + k); }
#pragma unroll
    for (int s = 0; s < 8; ++s) { c0 = __builtin_amdgcn_mfma_f32_16x16x32_bf16(af[s], bf0[s], c0, 0, 0, 0); c1 = __builtin_amdgcn_mfma_f32_16x16x32_bf16(af[s], bf1[s], c1, 0, 0, 0); }
    if (kq < 2) {
#pragma unroll
        for (int g = 0; g < 4; ++g) { red[wave * 256 + (kq * 4 + g) * 32 + r] = c0[g]; red[wave * 256 + (kq * 4 + g) * 32 + 16 + r] = c1[g]; } }
    __syncthreads();
    float s = 0.f;
    if (tid < 256) {
#pragma unroll
        for (int w = 0; w < 8; ++w) s += red[w * 256 + tid]; }
    return s;
}

struct Args { const void* in[25]; float* out; unsigned char* ws; float inv[8]; };

#define CAS __attribute__((address_space(4)))
#define PH_BEGIN const CAS Args* ap = (const CAS Args*)__builtin_amdgcn_kernarg_segment_ptr(); asm volatile("" : "+s"(ap)); GAS unsigned char* const wsl = (GAS unsigned char*)ap->ws; float* const out = (float*)(GAS float*)ap->out; (void)out; (void)wsl; int tid_l = threadIdx.x; asm volatile("" : "+v"(tid_l)); const int tid = tid_l, lane = tid & 63; (void)lane
#define INF(i) ((const float*)(const GAS float*)ap->in[i])
#define WSP(T, off) ((T*)(GAS T*)(wsl + (off)))
#define x_prompt INF(0)
#define x_sample INF(1)
#define p_prompt INF(2)
#define p_sample INF(3)
#define cache_k INF(4)
#define cache_v INF(5)
#define state_conv INF(6)
#define page_table ((const int*)(const GAS int*)ap->in[7])
#define w_in INF(8)
#define g_norm INF(9)
#define lq1 INF(10)
#define lk1 INF(11)
#define lq2 INF(12)
#define lk2 INF(13)
#define g_subln INF(14)
#define w_dw INF(15)
#define b_dw INF(16)
#define g_cln INF(17)
#define b_cln INF(18)
#define w_pw INF(19)
#define w_out INF(20)
#define g_ple INF(21)
#define w_pg INF(22)
#define w_ple INF(23)
#define g_final INF(24)
#define WIN WSP(bf16, WS_WIN)
#define WPW WSP(bf16, WS_WPW)
#define WOUT WSP(bf16, WS_WOUT)
#define WPG WSP(bf16, WS_WPG)
#define WPLE WSP(bf16, WS_WPLE)
#define RS0 WSP(float, WS_RS0)
#define SS1 WSP(float, WS_SS1)
#define SS2 WSP(float, WS_SS2)
#define ROPE WSP(float, WS_ROPE)
#define ZS WSP(float, WS_ZS)
#define H1S WSP(float, WS_H1S)
#define SS1S WSP(float, WS_SS1S)
#define SS2S WSP(float, WS_SS2S)
#define PART WSP(float, WS_PART)
#define XB WSP(bf16, WS_XB)
#define PB WSP(bf16, WS_PB)
#define QB WSP(bf16, WS_Q)
#define KB WSP(bf16, WS_K)
#define VB WSP(bf16, WS_V)
#define GA WSP(bf16, WS_GA)
#define GB WSP(bf16, WS_G)
#define GC WSP(bf16, WS_GC)
#define A2 WSP(bf16, WS_A2)
#define OM WSP(bf16, WS_OM)
#define A3 WSP(bf16, WS_A3)
#define PLE WSP(bf16, WS_PLE)
#define H1B WSP(bf16, WS_H1B)

__global__ void __launch_bounds__(NTHR, 2) hymba_fwd(Args args) {
    extern __shared__ __attribute__((aligned(16))) unsigned char lds[];
    LAS unsigned char* L = (LAS unsigned char*)lds;
    volatile LAS unsigned* MISC = (volatile LAS unsigned*)(L + MISC_OFF);
    const int tid = threadIdx.x, lane = tid & 63, wave = __builtin_amdgcn_readfirstlane(tid >> 6);
    const int G = gridDim.x, bx = blockIdx.x, vcu = (G % 8 == 0) ? (bx % 8) * (G / 8) + bx / 8 : bx;
    gu32* ctl = (gu32*)(args.ws + WS_CTL);
    for (int u = tid; u < (LDS_BYTES - LDSCTL_OFF) / 4; u += NTHR) ((LAS unsigned*)(L + LDSCTL_OFF))[u] = 0u;
    __syncthreads();
    XcdBarrier bar = xcd_barrier_post((unsigned*)(ctl + CW_BAR), MISC + 8);

    const int gw = vcu * NWAVES + wave, NGW = G * NWAVES;

#ifndef SKIP_P0
    {
        PH_BEGIN;
#ifndef REP_P0
#define REP_P0 1
#endif
#pragma unroll 1
        for (int rep0 = 0; rep0 < REP_P0; ++rep0) {
        LAS float* scr = (LAS float*)(L + RING_OFF + wave * 16384);
        constexpr int I_IN = (DMOD / 64) * (DIN / 32), I_PW = (1024 / 64) * (1024 / 32), I_OUT = (DMOD / 64) * (DMOD / 32), I_PG = I_OUT, I_PLE = (PLED / 64) * (DMOD / 32);
        constexpr int NITEMS = I_IN + I_PW + I_OUT + I_PG + I_PLE;
        for (int it = gw; it < NITEMS; it += NGW) {
            int r = it;
            if (r < I_IN) { const int nblk = DIN / 32, k0 = 64 * (r / nblk), n0 = 32 * (r % nblk); int orow = n0;
                if (n0 >= 4096 && n0 < 5120) { const int c = n0 - 4096; orow = 4096 + (c >> 7) * 256 + (c & 127); } else if (n0 >= 5120 && n0 < 6144) { const int c = n0 - 5120; orow = 4096 + (c >> 7) * 256 + 128 + (c & 127); }
                p0_transpose_item(w_in, DMOD, DIN, g_norm, WIN, k0, n0, orow, scr, lane); continue; } r -= I_IN;
            if (r < I_PW) { const int nblk = 1024 / 32; p0_transpose_item(w_pw, 1024, 1024, nullptr, WPW, 64 * (r / nblk), 32 * (r % nblk), 32 * (r % nblk), scr, lane); continue; } r -= I_PW;
            if (r < I_OUT) { const int nblk = DMOD / 32; p0_transpose_item(w_out, DMOD, DMOD, nullptr, WOUT, 64 * (r / nblk), 32 * (r % nblk), 32 * (r % nblk), scr, lane); continue; } r -= I_OUT;
            if (r < I_PG) { const int nblk = DMOD / 32; p0_transpose_item(w_pg, DMOD, DMOD, g_ple, WPG, 64 * (r / nblk), 32 * (r % nblk), 32 * (r % nblk), scr, lane); continue; } r -= I_PG;
            { const int nblk = DMOD / 32; p0_transpose_item(w_ple, PLED, DMOD, nullptr, WPLE, 64 * (r / nblk), 32 * (r % nblk), 32 * (r % nblk), scr, lane); }
        }
        for (int r = gw; r < MP; r += NGW) {
            GAS unsigned long long* o8 = (GAS unsigned long long*)(XB + (size_t)r * DMOD) + lane;
            if (r < MV) {
                const GAS f32x4* xr = (const GAS f32x4*)(r < MPR ? x_prompt + (size_t)r * DMOD : x_sample + (size_t)(r - MPR) * DMOD) + lane;
                f32x4 v[8]; float s = 0.f;
#pragma unroll
                for (int j = 0; j < 8; ++j) { v[j] = xr[64 * j]; s += (v[j].x * v[j].x + v[j].y * v[j].y) + (v[j].z * v[j].z + v[j].w * v[j].w); }
                s = wave_sum(s); if (lane == 0) RS0[r] = rsqrtf(s * (1.f / DMOD) + EPSN);
#pragma unroll
                for (int j = 0; j < 8; ++j) o8[64 * j] = (unsigned long long)pk2(v[j].x, v[j].y) | ((unsigned long long)pk2(v[j].z, v[j].w) << 32);
                const f32x4 pv = *((const GAS f32x4*)(r < MPR ? p_prompt + (size_t)r * PLED : p_sample + (size_t)(r - MPR) * PLED) + lane);
                *((GAS unsigned long long*)(PB + (size_t)r * PLED) + lane) = (unsigned long long)pk2(pv.x, pv.y) | ((unsigned long long)pk2(pv.z, pv.w) << 32);
            } else {
#pragma unroll
                for (int j = 0; j < 8; ++j) o8[64 * j] = 0ull;
                *((GAS unsigned long long*)(PB + (size_t)r * PLED) + lane) = 0ull;
                if (lane == 0) RS0[r] = 0.f;
            }
        }
        for (int e = bx * NTHR + tid; e < 2049 * 8; e += G * NTHR) { const int pos = e >> 3, i = e & 7; const float ang = (float)(pos == 2048 ? 16384 : pos) * ap->inv[i];
            float c, s; sincos_red(ang, c, s); ROPE[pos * 16 + i] = c; ROPE[pos * 16 + 8 + i] = s; }
        }
    }
#endif
    xcd_barrier(bar);

#ifndef SKIP_P1
    {
        PH_BEGIN;
        pg8::Gemm g{XB, WIN, MP, DIN, DMOD}; pg8::StaticOrder S; S.init(MP, DIN, G, bx);
        pg8::EpiIn E{(unsigned char*)wsl, out};
#ifndef REP_P1
#define REP_P1 1
#endif
#pragma unroll 1
        for (int rep1 = 0; rep1 < REP_P1; ++rep1)
        pg8::gemm_phase<pg8::EpiIn, pg8::StaticOrder, PG8_ALIGN, PG8_SP2>(L + RING_OFF, g, S, E);
        pg8::Gemm g2{PB, WPLE, MP, DMOD, PLED}; const int nfull = (33 * 28) % G;
        pg8::TailOrder S2{33, 8, G, bx, (nfull > 0 && nfull < G - 32) ? nfull : 0};
        pg8::EpiBf16<0> E2{PLE, DMOD, nullptr, 0, 0, 1.f};
        pg8::gemm_phase<pg8::EpiBf16<0>, pg8::TailOrder, PG8_ALIGN, PG8_SP2>(L + RING_OFF, g2, S2, E2);
    }
#endif
    xcd_barrier(bar);

#ifndef SKIP_P2
    {
        PH_BEGIN;
        LAS float* red = (LAS float*)(L + RING_OFF);
#ifndef SKIP_CONV
        for (int t = bx; t < MPR / 16; t += G) conv_tile((t >> 7) * SEQL, (t & 127) * 16, GB, w_dw, b_dw, g_cln, b_cln, A2, red, tid, wave, lane);
        if (bx == G - 1) conv_sample(state_conv, ZS, w_dw, b_dw, g_cln, b_cln, A2, out + ONCS, red, tid, wave, lane);
#endif
        __syncthreads();
#ifndef SKIP_ATTN
#ifndef REP_ATTN
#define REP_ATTN 1
#endif
        if (vcu < 256) {
            const int v = vcu, x = v >> 2, b = x >> 4, h = (x >> 1) & 7, m = x & 1, s = v & 3;
#pragma unroll 1
            for (int i = 0; i < 4 * REP_ATTN; ++i) { const int qb = ((i & 3) < 2) ? s : 7 - s, vh = i & 1;
                attn_body::attn_unit<8>(b, h * 128 + m * 64, h * 128 + m * 64, h * 128 + vh * 64, (h * 2 + m) * 128 + vh * 64, qb,
                                        (const attn_body::bf16*)QB, (const attn_body::bf16*)KB, (const attn_body::bf16*)VB, (attn_body::bf16*)OM, (char*)lds + RING_OFF); }
        }
#endif
#ifndef SKIP_DEC
#ifndef REP_DEC
#define REP_DEC 1
#endif
#pragma unroll 1
        for (int rep = 0; rep < REP_DEC; ++rep)
        for (int u = vcu; u < 256; u += G) decode_unit(u, u >> 5, (u & 31) * 4, ZS, cache_k, cache_v, page_table, PART, wave, lane);
#endif
    }
#endif
    xcd_barrier(bar);

#ifndef SKIP_P3
    {
        PH_BEGIN;
        pg8::Gemm g{A2, WPW, MP, 1024, 1024}; pg8::StaticOrder S; S.init(MP, 1024, G, bx);
        pg8::EpiPw E{GC, A3};
        pg8::gemm_phase<pg8::EpiPw, pg8::StaticOrder, PG8_ALIGN, PG8_SP2>(L + RING_OFF, g, S, E);
        const int c0 = (132 < G - 16) ? 132 : 0;
        if (bx >= c0) {
            const float lam = lam_value(lq1, lk1, lq2, lk2, lane);
            const int nw = (G - c0) * NWAVES, w0 = (bx - c0) * NWAVES + wave;
            for (int r = w0; r < MPR; r += nw) combine_row(r, lam, OM, GA, g_subln, A3, lane);
            if (w0 < 64) combine_sample(w0 >> 3, w0 & 7, lam, PART, ZS, GA, g_subln, A3, lane);
        }
    }
#endif
    xcd_barrier(bar);

#ifndef SKIP_P4
    {
        PH_BEGIN;
        pg8::Gemm g{A3, WOUT, MPR, DMOD, DMOD}; pg8::StaticOrder S; S.init(MPR, DMOD, G, bx);
        pg8::EpiOut E{x_prompt, H1B, SS1};
        pg8::gemm_phase<pg8::EpiOut, pg8::StaticOrder, false, PG8_SP2>(L + RING_OFF, g, S, E);
        __syncthreads();
        LAS float* red = (LAS float*)(L + RING_OFF + 8192);
        for (int mu = bx; mu < 64; mu += G) {
            const int n0 = mu * 32; const float acc = skinny_unit(A3 + (size_t)MPR * DMOD, WOUT, n0, red, tid, wave, lane);
            if (tid < 256) { const int row = tid >> 5, col = n0 + (tid & 31); const float v = x_sample[row * DMOD + col] + acc;
                H1S[row * DMOD + col] = v; H1B[(size_t)(MPR + row) * DMOD + col] = (bf16)f2bf(v);
                float s = v * v; s += __shfl_xor(s, 1); s += __shfl_xor(s, 2); s += __shfl_xor(s, 4); s += __shfl_xor(s, 8); s += __shfl_xor(s, 16);
                if ((tid & 31) == 0) SS1S[row * 64 + mu] = s; }
            __syncthreads();
        }
    }
#endif
    xcd_barrier(bar);

#ifndef SKIP_P5
    {
        PH_BEGIN;
        pg8::Gemm g{H1B, WPG, MPR, DMOD, DMOD}; pg8::StaticOrder S; S.init(MPR, DMOD, G, bx);
        pg8::EpiPg E{SS1, PLE, H1B, out + OY, SS2};
        pg8::gemm_phase<pg8::EpiPg, pg8::StaticOrder, false, PG8_SP2>(L + RING_OFF, g, S, E);
        __syncthreads();
        LAS float* red = (LAS float*)(L + RING_OFF + 8192);
        for (int mu = bx; mu < 64; mu += G) {
            const int n0 = mu * 32; const float acc = skinny_unit(H1B + (size_t)MPR * DMOD, WPG, n0, red, tid, wave, lane);
            if (tid < 256) { const int row = tid >> 5, col = n0 + (tid & 31);
                float ssum = SS1S[row * 64 + (tid & 31)] + SS1S[row * 64 + 32 + (tid & 31)];
                ssum += __shfl_xor(ssum, 1); ssum += __shfl_xor(ssum, 2); ssum += __shfl_xor(ssum, 4); ssum += __shfl_xor(ssum, 8); ssum += __shfl_xor(ssum, 16);
                const float rsv = rsqrtf(ssum * (1.f / DMOD) + EPSN);
                const float pl = bflo((unsigned)PLE[(size_t)(MPR + row) * DMOD + col]);
                const float v = H1S[row * DMOD + col] + sigm_(acc * rsv) * pl;
                out[OYS + row * DMOD + col] = v;
                float s = v * v; s += __shfl_xor(s, 1); s += __shfl_xor(s, 2); s += __shfl_xor(s, 4); s += __shfl_xor(s, 8); s += __shfl_xor(s, 16);
                if ((tid & 31) == 0) SS2S[row * 64 + mu] = s; }
            __syncthreads();
        }
    }
#endif
    xcd_barrier(bar);

#ifndef SKIP_P6
    { PH_BEGIN;
    for (int r = gw; r < MV; r += NGW) {
        float sv; GAS f32x4* hp;
        if (r < MPR) { sv = (lane < 8) ? SS2[(size_t)r * 8 + lane] : 0.f; hp = (GAS f32x4*)(out + OY + (size_t)r * DMOD) + lane; }
        else { sv = SS2S[(r - MPR) * 64 + lane]; hp = (GAS f32x4*)(out + OYS + (size_t)(r - MPR) * DMOD) + lane; }
        const float rsv = rsqrtf(wave_sum(sv) * (1.f / DMOD) + EPSN);
#pragma unroll
        for (int j = 0; j < 8; ++j) { const f32x4 g = *((const GAS f32x4*)g_final + lane + 64 * j); f32x4 v = hp[64 * j]; v = v * rsv * g; hp[64 * j] = v; }
    }
    }
#endif
}

extern "C" void kernel_launch(void* const* d_in, const int* in_sizes, int n_in, void* d_out, int out_size, void* d_ws, size_t ws_size, hipStream_t stream) {
    static int grid = 0;
    if (grid == 0) {
        if (n_in != 25 || (size_t)out_size != OUT_TOTAL || ws_size < WS_END) { fprintf(stderr, "kernel_launch: unexpected shapes (n_in %d, out %d, ws %zu); nothing launched\n", n_in, out_size, ws_size); grid = -1; return; }
        if (hipFuncSetAttribute((const void*)hymba_fwd, hipFuncAttributeMaxDynamicSharedMemorySize, LDS_BYTES) != hipSuccess) { fprintf(stderr, "kernel_launch: hipFuncSetAttribute failed\n"); grid = -1; return; }
        int per_cu = 0;
        if (hipOccupancyMaxActiveBlocksPerMultiprocessor(&per_cu, (const void*)hymba_fwd, NTHR, LDS_BYTES) != hipSuccess || per_cu < 1)
            fprintf(stderr, "kernel_launch: note: occupancy query reports %d workgroups per CU\n", per_cu);
        (void)hipGetLastError();
        grid = 256;
    }
    if (grid < 0) return;
    if (hipMemsetAsync((char*)d_ws + WS_CTL, 0, CTL_ZERO_BYTES, stream) != hipSuccess) { fprintf(stderr, "kernel_launch: hipMemsetAsync failed\n"); return; }
    Args a{};
    for (int i = 0; i < 25; ++i) a.in[i] = d_in[i];
    a.out = (float*)d_out; a.ws = (unsigned char*)d_ws;
    for (int i = 0; i < 8; ++i) a.inv[i] = (float)pow(500000.0, -(double)(2 * i) / 16.0);
    hipLaunchKernelGGL(hymba_fwd, dim3(grid), dim3(NTHR), LDS_BYTES, stream, a);
    const hipError_t le = hipPeekAtLastError();
    if (le != hipSuccess) fprintf(stderr, "kernel_launch: launch failed: %s\n", hipGetErrorName(le));
}
```
